# Optimizing an MI355X kernel written in HIP

```python
import math
import jax, jax.numpy as jnp
from jax import lax
import numpy as np

D_MODEL = 1024
BATCH = 8
SEQ = 4096
DEPTH = 2

CHUNK = 64
EPS = 1e-6
D_MLSTM = D_MODEL // 2
D_RGLRU = D_MODEL // 2
D_SSD = D_MODEL // 2
D_MIX = D_MLSTM + D_RGLRU + D_SSD
MLSTM_HEADS = 4
MLSTM_HEAD_DIM = D_MLSTM // MLSTM_HEADS
RGLRU_BLOCKS = 8
RGLRU_BLOCK_DIM = D_RGLRU // RGLRU_BLOCKS
RGLRU_C = 8.0
SSD_HEAD_DIM = 64
SSD_HEADS = D_SSD // SSD_HEAD_DIM
SSD_GROUPS = 2
SSD_STATE = 128
SSD_CONV_CH = D_SSD + 2 * SSD_GROUPS * SSD_STATE
CONV_WIDTH = 4
FFN_CONV_WIDTH = 3
D_FF = 2816
IN_SIZES = (D_MLSTM, D_MLSTM, MLSTM_HEADS, MLSTM_HEADS, D_RGLRU, D_RGLRU, D_SSD, SSD_CONV_CH, SSD_HEADS)
D_IN = D_MLSTM * 2 + MLSTM_HEADS * 2 + D_RGLRU * 2 + D_SSD + SSD_CONV_CH + SSD_HEADS

kernel_name = "hymba_mlstm_rglru_ssd_convffn_sandwich"


def rms_norm(x, g):
    xf = x.astype(jnp.float32)
    y = xf * lax.rsqrt(jnp.mean(xf * xf, axis=-1, keepdims=True) + EPS)
    return (y * g.astype(jnp.float32)).astype(x.dtype)


def causal_dwconv(x, w, b):
    K = w.shape[0]
    S = x.shape[1]
    xp = jnp.pad(x, ((0, 0), (K - 1, 0), (0, 0)))
    out = b
    for k in range(K):
        out = out + xp[:, k:k + S] * w[k]
    return out


def split_cols(p):
    idx = []
    acc = 0
    for s in IN_SIZES[:-1]:
        acc += s
        idx.append(acc)
    return jnp.split(p, idx, axis=-1)


def mlstm_group(x_m, o_pre, i_pre, f_pre, conv_w, conv_b, w_q, w_k, w_v, b_i, b_f, g_norm):
    Bsz, S, _ = x_m.shape
    H, dh, L = MLSTM_HEADS, MLSTM_HEAD_DIM, CHUNK
    NC = S // L
    f32 = jnp.float32
    x_c = jax.nn.silu(causal_dwconv(x_m, conv_w, conv_b))
    xc_h = x_c.reshape(Bsz, S, H, dh)
    xm_h = x_m.reshape(Bsz, S, H, dh)
    q = jnp.einsum('bshd,hde->bhse', xc_h, w_q).astype(f32).reshape(Bsz, H, NC, L, dh)
    k = (jnp.einsum('bshd,hde->bhse', xc_h, w_k).astype(f32) * (dh ** -0.5)).reshape(Bsz, H, NC, L, dh)
    v = jnp.einsum('bshd,hde->bhse', xm_h, w_v).astype(f32).reshape(Bsz, H, NC, L, dh)
    log_i = jnp.transpose((i_pre + b_i).astype(f32), (0, 2, 1)).reshape(Bsz, H, NC, L)
    log_f = jax.nn.log_sigmoid(jnp.transpose((f_pre + b_f).astype(f32), (0, 2, 1))).reshape(Bsz, H, NC, L)
    bcum = jnp.cumsum(log_f, axis=-1)
    b_tot = bcum[..., -1]
    causal = jnp.tril(jnp.ones((L, L), dtype=bool))
    d_intra = bcum[..., :, None] - bcum[..., None, :] + log_i[..., None, :]
    d_intra = jnp.where(causal, d_intra, -jnp.inf)
    w_state = b_tot[..., None] - bcum + log_i
    m_loc = jnp.max(w_state, axis=-1)
    ek = jnp.exp(w_state - m_loc[..., None])[..., None] * k
    c_loc = jnp.einsum('bhcld,bhcle->bhcde', ek, v)
    n_loc = jnp.sum(ek, axis=-2)

    def step(carry, inp):
        c_prev, n_prev, m_prev = carry
        c_l, n_l, m_l, bt = inp
        m_new = jnp.maximum(bt + m_prev, m_l)
        s_prev = jnp.exp(bt + m_prev - m_new)
        s_loc = jnp.exp(m_l - m_new)
        c_new = s_prev[..., None, None] * c_prev + s_loc[..., None, None] * c_l
        n_new = s_prev[..., None] * n_prev + s_loc[..., None] * n_l
        return (c_new, n_new, m_new), (c_prev, n_prev, m_prev)

    init = (jnp.zeros((Bsz, H, dh, dh), f32), jnp.zeros((Bsz, H, dh), f32), jnp.zeros((Bsz, H), f32))
    xs = (jnp.moveaxis(c_loc, 2, 0), jnp.moveaxis(n_loc, 2, 0), jnp.moveaxis(m_loc, 2, 0), jnp.moveaxis(b_tot, 2, 0))
    _, (c_st, n_st, m_st) = lax.scan(step, init, xs)
    c_st = jnp.moveaxis(c_st, 0, 2)
    n_st = jnp.moveaxis(n_st, 0, 2)
    m_st = jnp.moveaxis(m_st, 0, 2)
    inter_log = bcum + m_st[..., None]
    m_t = jnp.maximum(inter_log, jnp.max(d_intra, axis=-1))
    e_inter = jnp.exp(inter_log - m_t)
    scores = jnp.einsum('bhctd,bhcsd->bhcts', q, k) * jnp.exp(d_intra - m_t[..., None])
    num = jnp.einsum('bhcts,bhcse->bhcte', scores, v) + e_inter[..., None] * jnp.einsum('bhctd,bhcde->bhcte', q, c_st)
    den = jnp.sum(scores, axis=-1) + e_inter * jnp.einsum('bhctd,bhcd->bhct', q, n_st)
    h = num / jnp.maximum(jnp.abs(den), jnp.exp(-m_t))[..., None]
    h = jnp.transpose(h.reshape(Bsz, H, S, dh), (0, 2, 1, 3))
    h = jax.nn.sigmoid(o_pre.astype(f32)).reshape(Bsz, S, H, dh) * h
    h = h * lax.rsqrt(jnp.mean(h * h, axis=-1, keepdims=True) + EPS)
    h = h * g_norm.astype(f32).reshape(H, dh)
    return h.reshape(Bsz, S, D_MLSTM).astype(x_m.dtype)


def rglru_group(x_r, y_r, conv_w, conv_b, w_a, b_a, w_x, b_x, lam):
    Bsz, S, _ = x_r.shape
    f32 = jnp.float32
    xc = causal_dwconv(x_r, conv_w, conv_b)
    xb = xc.reshape(Bsz, S, RGLRU_BLOCKS, RGLRU_BLOCK_DIM)
    r = jax.nn.sigmoid(jnp.einsum('bsnd,nde->bsne', xb, w_a).reshape(Bsz, S, D_RGLRU) + b_a)
    i = jax.nn.sigmoid(jnp.einsum('bsnd,nde->bsne', xb, w_x).reshape(Bsz, S, D_RGLRU) + b_x)
    log_a = -RGLRU_C * r.astype(f32) * jax.nn.softplus(-lam.astype(f32))
    a = jnp.exp(log_a)
    u = jnp.sqrt(-jnp.expm1(2.0 * log_a)) * (i * xc).astype(f32)

    def combine(left, right):
        a1, b1 = left
        a2, b2 = right
        return a2 * a1, a2 * b1 + b2

    _, h = lax.associative_scan(combine, (a, u), axis=1)
    return h.astype(x_r.dtype) * jax.nn.gelu(y_r)


def ssd_group(z, xbc, dt_raw, conv_w, conv_b, dt_bias, a_log, d_skip, g_norm):
    Bsz, S, _ = z.shape
    H, P, G, N, L = SSD_HEADS, SSD_HEAD_DIM, SSD_GROUPS, SSD_STATE, CHUNK
    NC = S // L
    f32 = jnp.float32
    xbc = jax.nn.silu(causal_dwconv(xbc, conv_w, conv_b))
    xs, Bm, Cm = jnp.split(xbc, [D_SSD, D_SSD + G * N], axis=-1)
    xs = xs.reshape(Bsz, S, H, P)
    Bh = jnp.repeat(Bm.reshape(Bsz, S, G, N), H // G, axis=2)
    Ch = jnp.repeat(Cm.reshape(Bsz, S, G, N), H // G, axis=2)
    dt = jax.nn.softplus(dt_raw.astype(f32) + dt_bias.astype(f32))
    a = dt * (-jnp.exp(a_log.astype(f32)))
    x_c = xs.reshape(Bsz, NC, L, H, P)
    Bc = Bh.reshape(Bsz, NC, L, H, N)
    Cc = Ch.reshape(Bsz, NC, L, H, N)
    xdt = x_c * dt.reshape(Bsz, NC, L, H)[..., None]
    a_cum = jnp.cumsum(jnp.transpose(a.reshape(Bsz, NC, L, H), (0, 3, 1, 2)), axis=-1)
    causal = jnp.tril(jnp.ones((L, L), dtype=bool))
    seg = jnp.where(causal, a_cum[..., :, None] - a_cum[..., None, :], -jnp.inf)
    cb = jnp.einsum('bclhn,bcshn->bhcls', Cc, Bc) * jnp.exp(seg)
    y_diag = jnp.einsum('bhcls,bcshp->bclhp', cb, xdt)
    decay_states = jnp.exp(a_cum[..., -1:] - a_cum)
    states = jnp.einsum('bclhn,bhcl,bclhp->bchpn', Bc, decay_states, xdt)
    chunk_decay = jnp.exp(a_cum[..., -1])

    def step(carry, inp):
        st, dec = inp
        return dec[..., None, None] * carry + st, carry

    init = jnp.zeros((Bsz, H, P, N), states.dtype)
    _, s_start = lax.scan(step, init, (jnp.moveaxis(states, 1, 0), jnp.moveaxis(chunk_decay, 2, 0)))
    s_start = jnp.moveaxis(s_start, 0, 1)
    y_off = jnp.einsum('bclhn,bchpn,bhcl->bclhp', Cc, s_start, jnp.exp(a_cum))
    y = (y_diag + y_off).reshape(Bsz, S, H, P) + xs * d_skip[:, None]
    y = y.reshape(Bsz, S, D_SSD).astype(z.dtype)
    return rms_norm(y * jax.nn.silu(z), g_norm)


def conv_ffn(x, w_up, conv_w, conv_b, w_down):
    u = causal_dwconv(x @ w_up, conv_w, conv_b)
    g, v = jnp.split(u, 2, axis=-1)
    return (jax.nn.gelu(g) * v) @ w_down


def setup_inputs(seed: int = 0) -> dict:
    key = jax.random.key(seed)
    ks = jax.random.split(key, 40)
    f32 = jnp.float32

    def nrm(k, shape, scale):
        return jax.random.normal(k, shape, f32) * scale

    def gain(k, n):
        return 1.0 + 0.02 * jax.random.normal(k, (DEPTH, n), f32)

    u_a = jax.random.uniform(ks[20], (DEPTH, D_RGLRU), f32, minval=0.9, maxval=0.999)
    a_base = u_a ** (1.0 / RGLRU_C)
    dt0 = jnp.exp(jax.random.uniform(ks[24], (DEPTH, SSD_HEADS), f32, minval=math.log(1e-3), maxval=math.log(1e-1)))
    return {
        "x": jax.random.normal(ks[0], (BATCH, SEQ, D_MODEL), f32),
        "norm_mix_pre": gain(ks[1], D_MODEL),
        "norm_mix_post": gain(ks[2], D_MODEL),
        "norm_ffn_pre": gain(ks[3], D_MODEL),
        "norm_ffn_post": gain(ks[4], D_MODEL),
        "w_in": nrm(ks[5], (DEPTH, D_MODEL, D_IN), D_MODEL ** -0.5),
        "conv_m_w": nrm(ks[6], (DEPTH, CONV_WIDTH, D_MLSTM), CONV_WIDTH ** -0.5),
        "conv_m_b": nrm(ks[7], (DEPTH, D_MLSTM), 0.02),
        "w_q_m": nrm(ks[8], (DEPTH, MLSTM_HEADS, MLSTM_HEAD_DIM, MLSTM_HEAD_DIM), MLSTM_HEAD_DIM ** -0.5),
        "w_k_m": nrm(ks[9], (DEPTH, MLSTM_HEADS, MLSTM_HEAD_DIM, MLSTM_HEAD_DIM), MLSTM_HEAD_DIM ** -0.5),
        "w_v_m": nrm(ks[10], (DEPTH, MLSTM_HEADS, MLSTM_HEAD_DIM, MLSTM_HEAD_DIM), MLSTM_HEAD_DIM ** -0.5),
        "b_i_m": nrm(ks[11], (DEPTH, MLSTM_HEADS), 0.1),
        "b_f_m": jnp.linspace(3.0, 6.0, MLSTM_HEADS, dtype=f32)[None, :] + nrm(ks[12], (DEPTH, MLSTM_HEADS), 0.1),
        "norm_m": gain(ks[13], D_MLSTM),
        "conv_r_w": nrm(ks[14], (DEPTH, CONV_WIDTH, D_RGLRU), CONV_WIDTH ** -0.5),
        "conv_r_b": nrm(ks[15], (DEPTH, D_RGLRU), 0.02),
        "w_a_r": nrm(ks[16], (DEPTH, RGLRU_BLOCKS, RGLRU_BLOCK_DIM, RGLRU_BLOCK_DIM), RGLRU_BLOCK_DIM ** -0.5),
        "b_a_r": nrm(ks[17], (DEPTH, D_RGLRU), 0.02),
        "w_x_r": nrm(ks[18], (DEPTH, RGLRU_BLOCKS, RGLRU_BLOCK_DIM, RGLRU_BLOCK_DIM), RGLRU_BLOCK_DIM ** -0.5),
        "b_x_r": nrm(ks[19], (DEPTH, D_RGLRU), 0.02),
        "lam_r": jnp.log(a_base) - jnp.log1p(-a_base),
        "conv_s_w": nrm(ks[21], (DEPTH, CONV_WIDTH, SSD_CONV_CH), CONV_WIDTH ** -0.5),
        "conv_s_b": nrm(ks[22], (DEPTH, SSD_CONV_CH), 0.02),
        "dt_bias_s": dt0 + jnp.log(-jnp.expm1(-dt0)),
        "a_log_s": jnp.log(jax.random.uniform(ks[25], (DEPTH, SSD_HEADS), f32, minval=1.0, maxval=16.0)),
        "d_skip_s": 1.0 + nrm(ks[26], (DEPTH, SSD_HEADS), 0.1),
        "norm_s": gain(ks[27], D_SSD),
        "w_out": nrm(ks[28], (DEPTH, D_MIX, D_MODEL), D_MIX ** -0.5),
        "w_up": nrm(ks[29], (DEPTH, D_MODEL, 2 * D_FF), D_MODEL ** -0.5),
        "conv_f_w": nrm(ks[30], (DEPTH, FFN_CONV_WIDTH, 2 * D_FF), FFN_CONV_WIDTH ** -0.5),
        "conv_f_b": nrm(ks[31], (DEPTH, 2 * D_FF), 0.02),
        "w_down": nrm(ks[32], (DEPTH, D_FF, D_MODEL), D_FF ** -0.5),
    }


def reference(x, norm_mix_pre, norm_mix_post, norm_ffn_pre, norm_ffn_post, w_in,
              conv_m_w, conv_m_b, w_q_m, w_k_m, w_v_m, b_i_m, b_f_m, norm_m,
              conv_r_w, conv_r_b, w_a_r, b_a_r, w_x_r, b_x_r, lam_r,
              conv_s_w, conv_s_b, dt_bias_s, a_log_s, d_skip_s, norm_s,
              w_out, w_up, conv_f_w, conv_f_b, w_down):
    for l in range(DEPTH):
        h = rms_norm(x, norm_mix_pre[l])
        xm, om, im, fm, xr, yr, zs, xbcs, dts = split_cols(h @ w_in[l])
        y_m = mlstm_group(xm, om, im, fm, conv_m_w[l], conv_m_b[l], w_q_m[l], w_k_m[l], w_v_m[l],
                          b_i_m[l], b_f_m[l], norm_m[l])
        y_r = rglru_group(xr, yr, conv_r_w[l], conv_r_b[l], w_a_r[l], b_a_r[l], w_x_r[l], b_x_r[l], lam_r[l])
        y_s = ssd_group(zs, xbcs, dts, conv_s_w[l], conv_s_b[l], dt_bias_s[l], a_log_s[l], d_skip_s[l], norm_s[l])
        mix = jnp.concatenate([y_m, y_r, y_s], axis=-1) @ w_out[l]
        x = x + rms_norm(mix, norm_mix_post[l])
        h = rms_norm(x, norm_ffn_pre[l])
        x = x + rms_norm(conv_ffn(h, w_up[l], conv_f_w[l], conv_f_b[l], w_down[l]), norm_ffn_post[l])
    return x
```

```cpp
#include <hip/hip_runtime.h>
#include <cstdio>
#include <cstdint>
namespace pg8 {
#define PG8_LAS __attribute__((address_space(3)))
typedef unsigned short bf16_t;
typedef short bf16x8 __attribute__((ext_vector_type(8)));
typedef float f32x4 __attribute__((ext_vector_type(4)));
typedef unsigned u32x4 __attribute__((ext_vector_type(4)));
constexpr int BM = 256, BK = 64, HALF = 128, HTB = HALF * BK * 2  , STAGE_BYTES = 8 * HTB, NXCD = 8, WGM = 8;

__host__ __device__ __forceinline__ int lds_byte(int r, int c) { const int st = (r >> 4) * 2 + (c >> 5), rr = r & 15, cc = c & 31, ob = rr * 64 + cc * 2; return st * 1024 + (ob ^ (((ob >> 9) & 1) << 5)); }
__host__ __device__ __forceinline__ void stage_rc(int b, int& R, int& C) { const int st = b / 1024, sb = b % 1024, swz = sb ^ (((sb >> 9) & 1) << 5); R = (st >> 1) * 16 + swz / 64; C = (st & 1) * 32 + (swz % 64) / 2; }
__host__ __device__ __forceinline__ int perm32(int rho) { const int n = rho >> 4, i = rho & 15; return 8 * (i >> 2) + 4 * n + (i & 3); }

struct Unit { int pm, pn; };
struct Gemm { const bf16_t* A; const bf16_t* Bt; int M, N, K, lda; };

struct StaticOrder {
    int nM, nN, nwg, G, c;
    __host__ __device__ void init(int M, int N, int G_, int c_) { nM = M / BM; nN = N / BM; nwg = nM * nN; G = G_; c = c_; }
    __host__ __device__ bool next(int i, Unit& u) const {
        const long L = (long)i * G + c; if (L >= nwg) return false;
        int wgid = (int)L; { const int q = nwg / NXCD, r = nwg % NXCD, xcd = wgid % NXCD, off = wgid / NXCD; wgid = (xcd < r ? xcd * (q + 1) : r * (q + 1) + (xcd - r) * q) + off; }
        const int nig = WGM * nN, gid = wgid / nig, fm = gid * WGM, gsz = (nM - fm) < WGM ? (nM - fm) : WGM;
        u.pm = fm + ((wgid % nig) % gsz); u.pn = (wgid % nig) / gsz; return true;
    }
    __device__ __forceinline__ void a_ready(const Unit&) const {}
    __device__ __forceinline__ void done(const Unit&) const {}
};

__device__ __forceinline__ unsigned cvt_pk_bf16(float lo, float hi) { unsigned r; asm volatile("v_cvt_pk_bf16_f32 %0, %1, %2" : "=v"(r) : "v"(lo), "v"(hi)); return r; }
typedef float f32x2 __attribute__((ext_vector_type(2)));
struct EpiF32 {
    static constexpr bool PERM = false, AFTER_DRAIN = false;
    float* C; int ldc;
    __device__ __forceinline__ void operator()(const f32x4 (&acc)[2][2][4][2], const Unit& u, int wr, int wc, int fr, int fq) const {
        const int row0 = u.pm * BM + wr * 64 + fr, col0 = u.pn * BM + wc * 32 + 4 * fq;
#pragma unroll
        for (int ai = 0; ai < 2; ++ai)
#pragma unroll
            for (int m = 0; m < 4; ++m) { float* rowp = C + (size_t)(row0 + ai * HALF + m * 16) * ldc + col0;
#pragma unroll
                for (int bj = 0; bj < 2; ++bj)
#pragma unroll
                    for (int n = 0; n < 2; ++n) *(f32x4*)(rowp + bj * HALF + n * 16) = acc[ai][bj][m][n]; }
    }
};
struct EpiBf16P {
    static constexpr bool PERM = true, AFTER_DRAIN = false;
    bf16_t* O; int ldc;
    __device__ __forceinline__ void operator()(const f32x4 (&acc)[2][2][4][2], const Unit& u, int wr, int wc, int fr, int fq) const {
        const int row0 = u.pm * BM + wr * 64 + fr, col0 = u.pn * BM + wc * 32 + 8 * fq;
#pragma unroll
        for (int ai = 0; ai < 2; ++ai)
#pragma unroll
            for (int m = 0; m < 4; ++m) { bf16_t* rowp = O + (size_t)(row0 + ai * HALF + m * 16) * ldc + col0;
#pragma unroll
                for (int bj = 0; bj < 2; ++bj) { const f32x4 v0 = acc[ai][bj][m][0], v1 = acc[ai][bj][m][1];
                    u32x4 w; w.x = cvt_pk_bf16(v0[0], v0[1]); w.y = cvt_pk_bf16(v0[2], v0[3]); w.z = cvt_pk_bf16(v1[0], v1[1]); w.w = cvt_pk_bf16(v1[2], v1[3]);
                    *(u32x4*)(rowp + bj * HALF) = w; } }
    }
};
__device__ __forceinline__ float dpp_shr1(float old, float src) { return __builtin_bit_cast(float, __builtin_amdgcn_update_dpp(__builtin_bit_cast(int, old), __builtin_bit_cast(int, src), 0x111, 0xf, 0xf, false)); }
__device__ __forceinline__ float dpp_shr2(float old, float src) { return __builtin_bit_cast(float, __builtin_amdgcn_update_dpp(__builtin_bit_cast(int, old), __builtin_bit_cast(int, src), 0x112, 0xf, 0xf, false)); }
__device__ __forceinline__ float dpp_ror1(float src) { return __builtin_bit_cast(float, __builtin_amdgcn_update_dpp(0, __builtin_bit_cast(int, src), 0x121, 0xf, 0xf, false)); }
__device__ __forceinline__ float dpp_ror2(float src) { return __builtin_bit_cast(float, __builtin_amdgcn_update_dpp(0, __builtin_bit_cast(int, src), 0x122, 0xf, 0xf, false)); }
__device__ __forceinline__ float gelu_tanh(float x) {
    const float t = x * (1.0f + 0.044715f * x * x) * (-2.0f * 0.7978845608028654f * 1.4426950408889634f);
    return x * __builtin_amdgcn_rcpf(1.0f + __builtin_amdgcn_exp2f(t));
}
typedef unsigned u32x2 __attribute__((ext_vector_type(2)));
struct EpiConv {
    static constexpr bool PERM = true, AFTER_DRAIN = false;
    bf16_t* act; const float* cw; const float* cb; float* uhalo; float* ufix; PG8_LAS float* scr;
    __device__ __forceinline__ void operator()(const f32x4 (&acc)[2][2][4][2], const Unit& u, int wr, int wc, int fr, int fq) const {
        const int jg = u.pn * 128 + wc * 32 + 8 * fq;
        if (fr >= 14) {
#pragma unroll
            for (int ai = 0; ai < 2; ++ai) { const int grp = 2 * ai + wr; PG8_LAS float* base = scr + ((wc * 4 + grp) * 2 + (fr - 14)) * 64 + fq * 16;
#pragma unroll
                for (int bj = 0; bj < 2; ++bj)
#pragma unroll
                    for (int n = 0; n < 2; ++n) *(PG8_LAS f32x4*)(base + bj * 8 + n * 4) = acc[ai][bj][3][n]; }
            if (wr == 1) { float* hp = uhalo + ((size_t)u.pm * 2 + (fr - 14)) * 5632 + jg;
#pragma unroll
                for (int bj = 0; bj < 2; ++bj)
#pragma unroll
                    for (int n = 0; n < 2; ++n) *(f32x4*)(hp + bj * 2816 + 4 * n) = acc[1][bj][3][n]; }
        }
        if (wr == 0 && fr < 2) { float* fp = ufix + ((size_t)u.pm * 2 + fr) * 5632 + jg;
#pragma unroll
            for (int bj = 0; bj < 2; ++bj)
#pragma unroll
                for (int n = 0; n < 2; ++n) *(f32x4*)(fp + bj * 2816 + 4 * n) = acc[0][bj][0][n]; }
        asm volatile("s_waitcnt lgkmcnt(0)" ::: "memory"); __builtin_amdgcn_s_barrier(); asm volatile("" ::: "memory");
#pragma unroll
        for (int n = 0; n < 2; ++n) {
            f32x4 wg[3], wv[3];
#pragma unroll
            for (int k = 0; k < 3; ++k) { wg[k] = *(const f32x4*)(cw + k * 5632 + jg + 4 * n); wv[k] = *(const f32x4*)(cw + k * 5632 + 2816 + jg + 4 * n); }
            const f32x4 bg = *(const f32x4*)(cb + jg + 4 * n), bv = *(const f32x4*)(cb + 2816 + jg + 4 * n);
#pragma unroll
            for (int ai = 0; ai < 2; ++ai) {
                const int grp = 2 * ai + wr;
                f32x4 h0[2], h1[2];
                { const PG8_LAS float* base = scr + ((wc * 4 + (grp > 0 ? grp - 1 : 0)) * 2) * 64 + fq * 16 + n * 4;
#pragma unroll
                  for (int bj = 0; bj < 2; ++bj) { h0[bj] = *(const PG8_LAS f32x4*)(base + bj * 8); h1[bj] = *(const PG8_LAS f32x4*)(base + 64 + bj * 8); } }
#pragma unroll
                for (int m = 0; m < 4; ++m) {
                    f32x4 p1[2], p2[2], o;
#pragma unroll
                    for (int bj = 0; bj < 2; ++bj)
#pragma unroll
                        for (int j = 0; j < 4; ++j) { const float cur = acc[ai][bj][m][n][j]; float x1, x2;
                            if (m > 0) { const float pv = acc[ai][bj][m > 0 ? m - 1 : 0][n][j]; x1 = dpp_ror1(pv); x2 = dpp_ror2(pv); }
                            else { x1 = h1[bj][j]; x2 = (fr == 0) ? h0[bj][j] : h1[bj][j]; }
                            p1[bj][j] = dpp_shr1(x1, cur); p2[bj][j] = dpp_shr2(x2, cur); }
#pragma unroll
                    for (int j = 0; j < 4; ++j) {
                        const float g = bg[j] + wg[0][j] * p2[0][j] + wg[1][j] * p1[0][j] + wg[2][j] * acc[ai][0][m][n][j];
                        const float v = bv[j] + wv[0][j] * p2[1][j] + wv[1][j] * p1[1][j] + wv[2][j] * acc[ai][1][m][n][j];
                        o[j] = gelu_tanh(g) * v; }
                    const int rit = ai * HALF + wr * 64 + m * 16 + fr;
                    if (!(grp == 0 && m == 0 && fr < 2)) {
                        u32x2 w; w.x = cvt_pk_bf16(o[0], o[1]); w.y = cvt_pk_bf16(o[2], o[3]);
                        *(u32x2*)(act + (size_t)(u.pm * BM + rit) * 2816 + jg + 4 * n) = w; }
                }
            }
        }
    }
};
template <class Epi, class Sched, bool ALIGN_EPI = false, bool SP2 = false>
__device__ __forceinline__ void gemm_phase(PG8_LAS unsigned char* lds, const Gemm g, const Sched& S, const Epi& E) {
    int tid_ = threadIdx.x; asm volatile("" : "+v"(tid_));
    const int tid = tid_, wid = __builtin_amdgcn_readfirstlane(tid >> 6), lane = tid & 63, wr = wid >> 2, wc = wid & 3, fr = lane & 15, fq = lane >> 4;
    const int K = g.K, nt = K / BK;
    unsigned voffA[2], voffB[2];
#pragma unroll
    for (int i = 0; i < 2; ++i) { int R, C; stage_rc(tid * 16 + i * 8192, R, C); const int Rb = Epi::PERM ? ((R & ~31) + perm32(R & 31)) : R;
        voffA[i] = (unsigned)(R * g.lda + C) * 2u; voffB[i] = (unsigned)(Rb * K + C) * 2u; }
    const size_t kstep = (size_t)(BK * 2);
    const size_t hstep = (size_t)HALF * K * 2;
    const size_t tstep = 2 * hstep; const size_t hstepA = (size_t)HALF * g.lda * 2, tstepA = 2 * hstepA;
    const unsigned ldsw = (unsigned)wid * 1024u;
    const int aoff = lds_byte(wr * 64 + fr, fq * 8), boff = lds_byte(wc * 32 + fr, fq * 8);
#define PG8_SA(b, h) (((b) * 2 + (h)) * HTB)
#define PG8_SB(b, h) ((4 + (b) * 2 + (h)) * HTB)
#define PG8_STAGE(bufoff, gbase, voff) do { _Pragma("unroll") for (int _i = 0; _i < 2; ++_i) \
        __builtin_amdgcn_global_load_lds((const unsigned*)((const char*)(gbase) + (voff)[_i]), (PG8_LAS unsigned*)(lds + (bufoff) + ldsw + _i * 8192), 16, 0, 0); } while (0)
#define PG8_LDA(dst, b, h) do { _Pragma("unroll") for (int m = 0; m < 4; ++m) _Pragma("unroll") for (int k = 0; k < 2; ++k) dst[m][k] = *(const PG8_LAS bf16x8*)(lds + PG8_SA(b, h) + aoff + m * 2048 + k * 1024); } while (0)
#define PG8_LDB(dst, b, h) do { _Pragma("unroll") for (int n = 0; n < 2; ++n) _Pragma("unroll") for (int k = 0; k < 2; ++k) dst[n][k] = *(const PG8_LAS bf16x8*)(lds + PG8_SB(b, h) + boff + n * 2048 + k * 1024); } while (0)
#define PG8_MMA(ai, bj, At, Bt) do { __builtin_amdgcn_s_setprio(1); _Pragma("unroll") for (int m = 0; m < 4; ++m) _Pragma("unroll") for (int n = 0; n < 2; ++n) _Pragma("unroll") for (int k = 0; k < 2; ++k) \
        acc[ai][bj][m][n] = __builtin_amdgcn_mfma_f32_16x16x32_bf16(Bt[n][k], At[m][k], acc[ai][bj][m][n], 0, 0, 0); __builtin_amdgcn_s_setprio(0); } while (0)
#define PG8_WAIT_V(n) asm volatile("s_waitcnt vmcnt(" #n ")" ::: "memory")
#define PG8_WAIT_L(n) asm volatile("s_waitcnt lgkmcnt(" #n ")" ::: "memory")
#define PG8_BAR __builtin_amdgcn_s_barrier()
#define PG8_SCHED __builtin_amdgcn_sched_barrier(0)
    Unit cur, nxt; int ui = 0;
    if (!S.next(0, cur)) return;
    f32x4 acc[2][2][4][2];
#pragma unroll
    for (int a = 0; a < 2; ++a)
#pragma unroll
        for (int b = 0; b < 2; ++b)
#pragma unroll
            for (int m = 0; m < 4; ++m)
#pragma unroll
                for (int n = 0; n < 2; ++n) acc[a][b][m][n] = (f32x4){0.f, 0.f, 0.f, 0.f};
    bf16x8 At[4][2], B0[2][2], B1[2][2];
    const char* cA = (const char*)g.A + (size_t)cur.pm * tstepA; const char* cB = (const char*)g.Bt + (size_t)cur.pn * tstep;
    S.a_ready(cur);
    if constexpr (SP2) {
        PG8_STAGE(PG8_SB(0, 0), cB, voffB); PG8_STAGE(PG8_SB(0, 1), cB + hstep, voffB); PG8_STAGE(PG8_SA(0, 0), cA, voffA); PG8_STAGE(PG8_SA(0, 1), cA + hstepA, voffA);
        if (wr == 1) PG8_BAR;
        PG8_WAIT_V(2); PG8_BAR;
        PG8_STAGE(PG8_SB(1, 0), cB + kstep, voffB); PG8_STAGE(PG8_SA(1, 0), cA + kstep, voffA); PG8_STAGE(PG8_SB(1, 1), cB + hstep + kstep, voffB);
        PG8_WAIT_V(6); PG8_BAR;
    } else {
        PG8_STAGE(PG8_SB(0, 0), cB, voffB); PG8_STAGE(PG8_SA(0, 0), cA, voffA); PG8_STAGE(PG8_SB(0, 1), cB + hstep, voffB); PG8_STAGE(PG8_SA(0, 1), cA + hstepA, voffA);
        if (wr == 1) PG8_BAR;
        PG8_WAIT_V(4); PG8_BAR;
        PG8_STAGE(PG8_SB(1, 0), cB + kstep, voffB); PG8_STAGE(PG8_SA(1, 0), cA + kstep, voffA); PG8_STAGE(PG8_SB(1, 1), cB + hstep + kstep, voffB);
        PG8_WAIT_V(6); PG8_BAR;
    }
    for (;;) {
        const bool has_next = S.next(ui + 1, nxt);
        const char* nA = has_next ? (const char*)g.A + (size_t)nxt.pm * tstepA : cA; const char* nB = has_next ? (const char*)g.Bt + (size_t)nxt.pn * tstep : cB;
        for (int t = 0; t < nt; t += 2) {
            const bool last = (t == nt - 2);
            const char* a1 = cA + (size_t)(t + 1) * kstep;
            const char* a2 = last ? nA : cA + (size_t)(t + 2) * kstep; const char* b2 = last ? nB : cB + (size_t)(t + 2) * kstep;
            const char* a3 = a2 + kstep; const char* b3 = b2 + kstep;
            if (last && has_next) S.a_ready(nxt);
            if constexpr (SP2) {
            PG8_LDB(B0, 0, 0); PG8_LDB(B1, 0, 1); PG8_SCHED; PG8_LDA(At, 0, 0); PG8_STAGE(PG8_SA(1, 1), a1 + hstepA, voffA);
            PG8_WAIT_V(8); PG8_WAIT_L(0); PG8_BAR; PG8_MMA(0, 0, At, B0); PG8_MMA(0, 1, At, B1); PG8_BAR; PG8_SCHED;
            PG8_LDA(At, 0, 1); PG8_STAGE(PG8_SB(0, 0), b2, voffB); PG8_STAGE(PG8_SB(0, 1), b2 + hstep, voffB); PG8_STAGE(PG8_SA(0, 0), a2, voffA);
            PG8_WAIT_V(8); PG8_WAIT_L(0); PG8_BAR; PG8_MMA(1, 0, At, B0); PG8_MMA(1, 1, At, B1); PG8_BAR; PG8_SCHED;
            PG8_LDB(B0, 1, 0); PG8_LDB(B1, 1, 1); PG8_SCHED; PG8_LDA(At, 1, 0); PG8_STAGE(PG8_SA(0, 1), a2 + hstepA, voffA);
            PG8_WAIT_V(8); PG8_WAIT_L(0); PG8_BAR; PG8_MMA(0, 0, At, B0); PG8_MMA(0, 1, At, B1); PG8_BAR; PG8_SCHED;
            PG8_LDA(At, 1, 1); PG8_STAGE(PG8_SB(1, 0), b3, voffB); PG8_STAGE(PG8_SB(1, 1), b3 + hstep, voffB); PG8_STAGE(PG8_SA(1, 0), a3, voffA);
            PG8_WAIT_V(8); PG8_WAIT_L(0); PG8_BAR; PG8_MMA(1, 0, At, B0); PG8_MMA(1, 1, At, B1); PG8_BAR; PG8_SCHED;
            } else {
            PG8_LDB(B0, 0, 0); PG8_SCHED; PG8_LDA(At, 0, 0); PG8_STAGE(PG8_SA(1, 1), a1 + hstepA, voffA);
            PG8_WAIT_L(8); PG8_BAR; PG8_WAIT_L(0); PG8_MMA(0, 0, At, B0); PG8_BAR; PG8_SCHED;
            PG8_LDB(B1, 0, 1); PG8_STAGE(PG8_SB(0, 0), b2, voffB);
            PG8_BAR; PG8_WAIT_L(0); PG8_MMA(0, 1, At, B1); PG8_BAR;
            PG8_LDA(At, 0, 1); PG8_STAGE(PG8_SA(0, 0), a2, voffA);
            PG8_BAR; PG8_WAIT_L(0); PG8_MMA(1, 0, At, B0); PG8_BAR; PG8_SCHED;
            PG8_STAGE(PG8_SB(0, 1), b2 + hstep, voffB);
            PG8_WAIT_V(6); PG8_BAR; PG8_MMA(1, 1, At, B1); PG8_BAR;
            PG8_LDB(B0, 1, 0); PG8_SCHED; PG8_LDA(At, 1, 0); PG8_STAGE(PG8_SA(0, 1), a2 + hstepA, voffA);
            PG8_WAIT_L(8); PG8_BAR; PG8_WAIT_L(0); PG8_MMA(0, 0, At, B0); PG8_BAR; PG8_SCHED;
            PG8_LDB(B1, 1, 1); PG8_STAGE(PG8_SB(1, 0), b3, voffB);
            PG8_BAR; PG8_WAIT_L(0); PG8_MMA(0, 1, At, B1); PG8_BAR;
            PG8_LDA(At, 1, 1); PG8_STAGE(PG8_SA(1, 0), a3, voffA);
            PG8_BAR; PG8_WAIT_L(0); PG8_MMA(1, 0, At, B0); PG8_BAR; PG8_SCHED;
            PG8_STAGE(PG8_SB(1, 1), b3 + hstep, voffB);
            PG8_WAIT_V(6); PG8_BAR; PG8_MMA(1, 1, At, B1); PG8_BAR;
            }
        }
        if constexpr (ALIGN_EPI) { if (wr == 0) PG8_BAR; }
        if constexpr (!Epi::AFTER_DRAIN) { E(acc, cur, wr, wc, fr, fq); S.done(cur); }
        if (!has_next) break;
#pragma unroll
        for (int a = 0; a < 2; ++a)
#pragma unroll
            for (int b = 0; b < 2; ++b)
#pragma unroll
                for (int m = 0; m < 4; ++m)
#pragma unroll
                    for (int n = 0; n < 2; ++n) acc[a][b][m][n] = (f32x4){0.f, 0.f, 0.f, 0.f};
        cur = nxt; cA = nA; cB = nB; ++ui;
        if constexpr (ALIGN_EPI) { if (wr == 1) PG8_BAR; }
    }
    PG8_WAIT_V(0);
    if constexpr (!ALIGN_EPI) { if (wr == 0) PG8_BAR; }
    PG8_BAR;
    if constexpr (Epi::AFTER_DRAIN) { E.fused(acc, cur, wr, wc, fr, fq, lds, wid, lane); S.done(cur); }
#undef PG8_SA
#undef PG8_SB
#undef PG8_STAGE
#undef PG8_LDA
#undef PG8_LDB
#undef PG8_MMA
#undef PG8_WAIT_V
#undef PG8_WAIT_L
#undef PG8_BAR
#undef PG8_SCHED
}
}


#ifndef PG8_SP2
#define PG8_SP2 true
#endif
#ifndef PG8_ALIGN
#define PG8_ALIGN true
#endif
constexpr int NWAVES = 8, NTHR = 512;
#ifndef MK_PER_PHASE
#define MK_PER_PHASE 0
#endif
constexpr int BATCH = 8, SEQ = 4096, TOK = BATCH * SEQ, DM = 1024, NP = 3584, DFF = 2816, NUP = 5632, KMIX = 1536, NCHK = 64, DEPTH = 2;
constexpr int PC_XM = 0, PC_XR = 512, PC_XBC = 1024, PC_OM = 2048, PC_YR = 2560, PC_ZS = 3072;
constexpr float EPS = 1e-6f;
constexpr int NPHASES = 1 + 10 * DEPTH;
constexpr size_t W_IN = 0, W_OUT = W_IN + (size_t)3600 * 1024, W_UP = W_OUT + (size_t)1024 * 1536, W_DN = W_UP + (size_t)5632 * 1024, W_Q = W_DN + (size_t)1024 * 2816,
                 W_K = W_Q + 65536, W_V = W_K + 65536, W_A = W_V + 65536, W_X = W_A + 32768, W_LAYER = W_X + 32768;
constexpr size_t MiB = 1u << 20;
constexpr size_t WS_CTL = 0, CTL_ZERO_BYTES = 1 * MiB;
constexpr size_t WS_W = 1 * MiB, WS_XN = 56 * MiB, WS_P = 120 * MiB, WS_PS = 344 * MiB, WS_MC = 346 * MiB, WS_SS = 410 * MiB, WS_Y = WS_MC, WS_MN = 474 * MiB, WS_MS = 475 * MiB,
                 WS_RG = 476 * MiB, WS_HALO = 479 * MiB, WS_END = 491 * MiB;
static_assert(WS_W + 2 * W_LAYER * 2 <= WS_XN, "weights fit");
constexpr int CW_TMO = 0, CW_BAR = 4096;
constexpr int RING_OFF = 0, RING_BYTES = 131072, LDSCTL_OFF = RING_BYTES, MISC_OFF = LDSCTL_OFF + 320, PTR_OFF = LDSCTL_OFF + 512, EPI_OFF = LDSCTL_OFF + 1024, LDS_BYTES = 147456;

#define GAS __attribute__((address_space(1)))
#define LAS __attribute__((address_space(3)))
typedef unsigned short bf16;
typedef unsigned v4u __attribute__((ext_vector_type(4)));
typedef unsigned v2u __attribute__((ext_vector_type(2)));
typedef float f32x4 __attribute__((ext_vector_type(4)));
typedef short bf16x8 __attribute__((ext_vector_type(8)));
typedef GAS unsigned gu32;
#define RLX_AGENT __ATOMIC_RELAXED, __HIP_MEMORY_SCOPE_AGENT
#define LDS_WAIT() asm volatile("s_waitcnt lgkmcnt(0)" ::: "memory")
#define VM_WAIT() asm volatile("s_waitcnt vmcnt(0)" ::: "memory")
__device__ __forceinline__ unsigned f2bf(float f) { unsigned u = __builtin_bit_cast(unsigned, f); return (u + 0x7fffu + ((u >> 16) & 1u)) >> 16; }
__device__ __forceinline__ unsigned pk2(float lo, float hi) { return f2bf(lo) | (f2bf(hi) << 16); }
__device__ __forceinline__ float bf2f(unsigned b) { return __builtin_bit_cast(float, b << 16); }
__device__ __forceinline__ float lo16(unsigned w) { return __builtin_bit_cast(float, w << 16); }
__device__ __forceinline__ float hi16(unsigned w) { return __builtin_bit_cast(float, w & 0xffff0000u); }
__device__ __forceinline__ float sigmoidf_(float x) { return __builtin_amdgcn_rcpf(1.0f + __expf(-x)); }
__device__ __forceinline__ float siluf_(float x) { return x * sigmoidf_(x); }
__device__ __forceinline__ float softplusf_(float x) { return fmaxf(x, 0.f) + log1pf(__expf(-fabsf(x))); }
#define XB_TMO      128
#define XB_XCNT(j)  (256  + 64 * (j))
#define XB_XSUB(j)  (1280 + 64 * (j))
#define XB_XGEN(j)  (2304 + 64 * (j))
#define XB_TOP      3328
#define XB_TOPGEN   3392
#define XCD_BAR_WORDS 3456
#define XB_SPIN_CAP (1u << 18)

__device__ __forceinline__ unsigned xb_ld(unsigned* p)              { return __hip_atomic_load(p, __ATOMIC_RELAXED, __HIP_MEMORY_SCOPE_AGENT); }
__device__ __forceinline__ unsigned xb_add(unsigned* p, unsigned v) { return __hip_atomic_fetch_add(p, v, __ATOMIC_RELAXED, __HIP_MEMORY_SCOPE_AGENT); }
__device__ __forceinline__ unsigned xb_xcc_id() { return (unsigned)__builtin_amdgcn_s_getreg((3 << 11) | 20) & 0xFu; }
#define XB_SPIN(cond, bar) do { unsigned _sp = 0; while (cond) { __builtin_amdgcn_s_sleep(1); \
    if ((++_sp & 255u) == 0u) { if (xb_ld(&(bar)[XB_TMO])) break; if (_sp > XB_SPIN_CAP) { atomicAdd(&(bar)[XB_TMO], 1u); break; } } } } while (0)

struct XcdBarrier {
    unsigned* bar; unsigned x;
    volatile LAS unsigned* st;
};

__device__ __forceinline__ XcdBarrier xcd_barrier_post(unsigned* bar, volatile LAS unsigned* st) {
    XcdBarrier b; b.bar = bar; b.x = xb_xcc_id(); b.st = st;
    if (threadIdx.x == 0) (void)xb_add(&bar[XB_XCNT(b.x)], 1u);
    return b;
}
__device__ __forceinline__ void xcd_barrier_complete(unsigned* bar, unsigned x, unsigned& nloc, unsigned& nx) {
    const unsigned G = gridDim.x * gridDim.y * gridDim.z;
    unsigned sum, cnt, mine, sp = 0u;
    for (;;) {
        sum = 0u; cnt = 0u; mine = 0u;
#pragma unroll
        for (unsigned j = 0; j < 16; ++j) { const unsigned c = xb_ld(&bar[XB_XCNT(j)]); sum += c; cnt += (c > 0u) ? 1u : 0u; mine = (j == x) ? c : mine; }
        if (sum == G) break;
        __builtin_amdgcn_s_sleep(1);
        if ((++sp & 255u) == 0u) { if (xb_ld(&bar[XB_TMO])) break; if (sp > XB_SPIN_CAP) { atomicAdd(&bar[XB_TMO], 1u); break; } }
    }
    nloc = mine > 0u ? mine : 1u; nx = cnt > 0u ? cnt : 1u;
}

__device__ __forceinline__ void xcd_barrier(const XcdBarrier& b) {
    asm volatile("s_waitcnt vmcnt(0)" ::: "memory");
    __syncthreads();
    if (threadIdx.x == 0) {
        unsigned* bar = b.bar;
        __builtin_amdgcn_s_waitcnt(0);
        unsigned nloc = b.st[0], nx = b.st[1];
        if (nloc == 0u) { xcd_barrier_complete(bar, b.x, nloc, nx); b.st[0] = nloc; b.st[1] = nx; }
        const unsigned old = xb_add(&bar[XB_XSUB(b.x)], 1u);
        const unsigned gen = old / nloc;
        if (old + 1u == (gen + 1u) * nloc) {
            __builtin_amdgcn_fence(__ATOMIC_RELEASE, "agent");
            asm volatile("s_waitcnt vmcnt(0)" ::: "memory");
            const unsigned og = xb_add(&bar[XB_TOP], 1u);
            const unsigned tg = og / nx;
            if (og + 1u == (tg + 1u) * nx) xb_add(&bar[XB_TOPGEN], 1u);
            else XB_SPIN(xb_ld(&bar[XB_TOPGEN]) == tg, bar);
            __builtin_amdgcn_fence(__ATOMIC_ACQUIRE, "agent");
            xb_add(&bar[XB_XGEN(b.x)], 1u);
            asm volatile("s_waitcnt vmcnt(0)" ::: "memory");
        } else {
            XB_SPIN(xb_ld(&bar[XB_XGEN(b.x)]) == gen, bar);
            __builtin_amdgcn_fence(__ATOMIC_ACQUIRE, "agent");
            asm volatile("s_waitcnt vmcnt(0)" ::: "memory");
        }
    }
    __syncthreads();
}

struct Args { const float* in[32]; float* out; unsigned char* ws; int ph_lo, ph_hi; };
struct Frame {
    LAS unsigned char* lds; volatile LAS unsigned* MISC; gu32* ctl;
    int tid, lane, wave, vcu, G;
    unsigned char* ws;
};
__device__ __forceinline__ const float* inp(const Frame& F, int k) {
    const volatile LAS unsigned* t = (const volatile LAS unsigned*)(F.lds + PTR_OFF) + 2 * k;
    const unsigned lo = __builtin_amdgcn_readfirstlane(t[0]), hi = __builtin_amdgcn_readfirstlane(t[1]);
    return (const float*)(((unsigned long long)hi << 32) | lo);
}
__device__ __forceinline__ const bf16* wlayer(const Frame& F, int l) { return (const bf16*)(F.ws + WS_W) + (size_t)l * W_LAYER; }

__device__ __forceinline__ float wave_sum(float v) {
#pragma unroll
    for (int o = 1; o < 64; o <<= 1) v += __shfl_xor(v, o);
    return v;
}
__device__ __forceinline__ float wave_maxf(float v) {
#pragma unroll
    for (int o = 1; o < 64; o <<= 1) v = fmaxf(v, __shfl_xor(v, o));
    return v;
}
__device__ __forceinline__ float wave_incl_sum(float v, int lane) {
#pragma unroll
    for (int o = 1; o < 64; o <<= 1) { const float t = __shfl_up(v, o); if (lane >= o) v += t; }
    return v;
}
__device__ __forceinline__ float wave_incl_max(float v, int lane) {
#pragma unroll
    for (int o = 1; o < 64; o <<= 1) { const float t = __shfl_up(v, o); if (lane >= o) v = fmaxf(v, t); }
    return v;
}
__device__ __forceinline__ void lds_addf(LAS float* p, float v) { (void)__hip_atomic_fetch_add(p, v, __ATOMIC_RELAXED, __HIP_MEMORY_SCOPE_WORKGROUP); }
__device__ __forceinline__ float logsigmoidf_(float x) { return fminf(x, 0.f) - log1pf(__expf(-fabsf(x))); }

#define MFMA16(btf, af, c) __builtin_amdgcn_mfma_f32_16x16x32_bf16(btf, af, c, 0, 0, 0)
__device__ __forceinline__ bf16x8 ldl8(const LAS bf16* p) { return *(const LAS bf16x8*)p; }
__device__ __forceinline__ bf16x8 ldg8(const bf16* p) { return *(const GAS bf16x8*)p; }
__device__ __forceinline__ v2u pack4(f32x4 v) { v2u w; w.x = pk2(v[0], v[1]); w.y = pk2(v[2], v[3]); return w; }
__device__ __forceinline__ v4u pack8(const float (&o)[8]) { v4u w; w.x = pk2(o[0], o[1]); w.y = pk2(o[2], o[3]); w.z = pk2(o[4], o[5]); w.w = pk2(o[6], o[7]); return w; }

template <bool SILU> __device__ __forceinline__ void conv8(const bf16* pr, int pos, const float* w, int wstride, const float* bias, float (&o)[8], v4u& raw) {
    const f32x4 b0 = *(const GAS f32x4*)bias, b1 = *(const GAS f32x4*)(bias + 4);
    o[0] = b0[0]; o[1] = b0[1]; o[2] = b0[2]; o[3] = b0[3]; o[4] = b1[0]; o[5] = b1[1]; o[6] = b1[2]; o[7] = b1[3];
#pragma unroll
    for (int k = 0; k < 4; ++k) {
        v4u x = (v4u){0u, 0u, 0u, 0u};
        if (pos - 3 + k >= 0) x = *(const GAS v4u*)(pr + (k - 3) * NP);
        if (k == 3) raw = x;
        const f32x4 w0 = *(const GAS f32x4*)(w + k * wstride), w1 = *(const GAS f32x4*)(w + k * wstride + 4);
        o[0] += w0[0] * lo16(x.x); o[1] += w0[1] * hi16(x.x); o[2] += w0[2] * lo16(x.y); o[3] += w0[3] * hi16(x.y);
        o[4] += w1[0] * lo16(x.z); o[5] += w1[1] * hi16(x.z); o[6] += w1[2] * lo16(x.w); o[7] += w1[3] * hi16(x.w);
    }
    if (SILU) {
#pragma unroll
        for (int i = 0; i < 8; ++i) o[i] = siluf_(o[i]);
    }
}
template <bool SILU> __device__ __forceinline__ void conv_t8(const bf16* pc, int pos0, const float* w, int wstride, float bias, float (&o)[8]) {
    float x[11];
#pragma unroll
    for (int i = 0; i < 11; ++i) { x[i] = 0.f; if (pos0 + i - 3 >= 0) x[i] = bf2f((unsigned)*(const GAS bf16*)(pc + (i - 3) * NP)); }
    const float w0 = w[0], w1 = w[wstride], w2 = w[2 * wstride], w3 = w[3 * wstride];
#pragma unroll
    for (int i = 0; i < 8; ++i) { float v = bias + w0 * x[i] + w1 * x[i + 1] + w2 * x[i + 2] + w3 * x[i + 3]; o[i] = SILU ? siluf_(v) : v; }
}

template <bool SMALL> __device__ __forceinline__ void tr_item(const float* src, int ldw, int srccol0, int k0, bf16* dst, int ldo, int dstrow0, const float* gain, float scal, LAS float* scr, int lane) {
    const int nn = lane & 31;
    int sc = srccol0 + nn; bool ok = true;
    if (SMALL) { sc = nn < 8 ? 1024 + nn : 3592 + (nn - 8); ok = nn < 16; }
#pragma unroll 8
    for (int i = 0; i < 32; ++i) { const int kk = 2 * i + (lane >> 5); float v = 0.f;
        if (ok) v = *(const GAS float*)(src + (size_t)(k0 + kk) * ldw + sc) * (gain ? *(const GAS float*)(gain + k0 + kk) : 1.0f) * scal;
        scr[kk * 33 + nn] = v; }
    LDS_WAIT(); asm volatile("" ::: "memory");
    const int c = lane & 7;
#pragma unroll
    for (int j = 0; j < 4; ++j) { const int n = (lane >> 3) + 8 * j; const LAS float* s = scr + (8 * c) * 33 + n;
        v4u o; o.x = pk2(s[0 * 33], s[1 * 33]); o.y = pk2(s[2 * 33], s[3 * 33]); o.z = pk2(s[4 * 33], s[5 * 33]); o.w = pk2(s[6 * 33], s[7 * 33]);
        if (!SMALL || n < 16) *(GAS v4u*)(dst + (size_t)(dstrow0 + n) * ldo + k0 + 8 * c) = o; }
    LDS_WAIT(); asm volatile("" ::: "memory");
}
__device__ __forceinline__ int pcol_src(int n0) {
    if (n0 < 512) return n0;
    if (n0 < 1024) return 1032 + (n0 - 512);
    if (n0 < 2048) return 2568 + (n0 - 1024);
    if (n0 < 2560) return 512 + (n0 - 2048);
    if (n0 < 3072) return 1544 + (n0 - 2560);
    return 2056 + (n0 - 3072);
}
__device__ __forceinline__ void p0_prologue(const Frame& F) {
    LAS float* scr = (LAS float*)(F.lds + RING_OFF + F.wave * 16384);
    const int gw = F.vcu * NWAVES + F.wave, NGW = F.G * NWAVES;
    constexpr int I_IN = 16 * 113, I_OUT = 24 * 32, I_UP = 16 * 176, I_DN = 44 * 32, I_QKV = 3 * 4 * 8, I_AX = 2 * 8 * 2, I_LAYER = I_IN + I_OUT + I_UP + I_DN + I_QKV + I_AX;
    for (int it = gw; it < DEPTH * I_LAYER; it += NGW) {
        const int l = it / I_LAYER; int r = it - l * I_LAYER;
        bf16* W = (bf16*)(F.ws + WS_W) + (size_t)l * W_LAYER;
        if (r < I_IN) { const int kb = r / 113, nb = r % 113; const float* src = inp(F, 5) + (size_t)l * 1024 * 3600; const float* gain = inp(F, 1) + l * 1024;
            if (nb < 112) tr_item<false>(src, 3600, pcol_src(32 * nb), 64 * kb, W + W_IN, 1024, 32 * nb, gain, 1.0f, scr, F.lane);
            else tr_item<true>(src, 3600, 0, 64 * kb, W + W_IN, 1024, 3584, gain, 1.0f, scr, F.lane);
            continue; }
        r -= I_IN;
        if (r < I_OUT) { const int kb = r / 32, nb = r % 32; tr_item<false>(inp(F, 27) + (size_t)l * 1536 * 1024, 1024, 32 * nb, 64 * kb, W + W_OUT, 1536, 32 * nb, nullptr, 1.0f, scr, F.lane); continue; }
        r -= I_OUT;
        if (r < I_UP) { const int kb = r / 176, nb = r % 176, n0 = 32 * nb, pn = n0 >> 8, wi = n0 & 255; const int sc = wi < 128 ? 128 * pn + wi : 2816 + 128 * pn + (wi - 128);
            tr_item<false>(inp(F, 28) + (size_t)l * 1024 * 5632, 5632, sc, 64 * kb, W + W_UP, 1024, n0, inp(F, 3) + l * 1024, 1.0f, scr, F.lane); continue; }
        r -= I_UP;
        if (r < I_DN) { const int kb = r / 32, nb = r % 32; tr_item<false>(inp(F, 31) + (size_t)l * 2816 * 1024, 1024, 32 * nb, 64 * kb, W + W_DN, 2816, 32 * nb, nullptr, 1.0f, scr, F.lane); continue; }
        r -= I_DN;
        if (r < I_QKV) { const int which = r / 32, h = (r % 32) / 8, kb = (r % 8) / 4, nb = r % 4;
            const float* src = (which == 0 ? inp(F, 8) : which == 1 ? inp(F, 9) : inp(F, 10)) + ((size_t)l * 4 + h) * 16384;
            tr_item<false>(src, 128, 32 * nb, 64 * kb, W + W_Q + (size_t)which * 65536 + h * 16384, 128, 32 * nb, nullptr, which == 1 ? 0.08838834764831845f : 1.0f, scr, F.lane); continue; }
        r -= I_QKV;
        { const int which = r / 16, n = (r % 16) / 2, nb = r % 2;
            const float* src = (which == 0 ? inp(F, 16) : inp(F, 18)) + ((size_t)l * 8 + n) * 4096;
            tr_item<false>(src, 64, 32 * nb, 0, W + (which == 0 ? W_A : W_X) + n * 4096, 64, 32 * nb, nullptr, 1.0f, scr, F.lane); }
    }
    bf16* XN = (bf16*)(F.ws + WS_XN);
    for (int m = gw; m < TOK; m += NGW) {
        const GAS f32x4* xr = (const GAS f32x4*)(inp(F, 0) + (size_t)m * DM) + F.lane;
        f32x4 v[4]; float s = 0.f;
#pragma unroll
        for (int j = 0; j < 4; ++j) { v[j] = xr[64 * j]; s += (v[j][0] * v[j][0] + v[j][1] * v[j][1]) + (v[j][2] * v[j][2] + v[j][3] * v[j][3]); }
        const float rs = 1.0f / sqrtf(wave_sum(s) * (1.0f / DM) + EPS);
        GAS v2u* o8 = (GAS v2u*)(XN + (size_t)m * DM) + F.lane;
#pragma unroll
        for (int j = 0; j < 4; ++j) { v2u w; w.x = pk2(v[j][0] * rs, v[j][1] * rs); w.y = pk2(v[j][2] * rs, v[j][3] * rs); o8[64 * j] = w; }
    }
}

__device__ __forceinline__ void small_cols(const Frame& F, int l) {
    const bf16* XN = (const bf16*)(F.ws + WS_XN); const bf16* Ws = wlayer(F, l) + W_IN + (size_t)3584 * 1024; float* PS = (float*)(F.ws + WS_PS);
    const int q = F.lane >> 4, i = F.lane & 15;
    for (int rb = blockIdx.x * NWAVES + F.wave; rb < TOK / 16; rb += F.G * NWAVES) {
        const bf16* ap = XN + (size_t)(rb * 16 + i) * DM + 8 * q; const bf16* bp = Ws + (size_t)i * DM + 8 * q;
        f32x4 acc = (f32x4){0.f, 0.f, 0.f, 0.f};
#pragma unroll 8
        for (int kk = 0; kk < 32; ++kk) acc = MFMA16(ldg8(bp + 32 * kk), ldg8(ap + 32 * kk), acc);
        *(GAS f32x4*)(PS + (size_t)(rb * 16 + i) * 16 + 4 * q) = acc;
    }
}

__device__ __forceinline__ void mlstm_load(const Frame& F, int l, int b, int h, int c, LAS bf16* XC, LAS bf16* XM) {
    const bf16* P = (const bf16*)(F.ws + WS_P);
    const float* cw = inp(F, 6) + (size_t)l * 4 * 512 + h * 128; const float* cbias = inp(F, 7) + l * 512 + h * 128;
#pragma unroll
    for (int i = 0; i < 2; ++i) { const int u = F.tid + NTHR * i, t = u >> 4, cg = u & 15, pos = c * 64 + t;
        const bf16* pr = P + (size_t)(b * SEQ + pos) * NP + PC_XM + h * 128 + cg * 8;
        float o[8]; v4u raw; conv8<true>(pr, pos, cw + cg * 8, 512, cbias + cg * 8, o, raw);
        *(LAS v4u*)(XC + t * 136 + cg * 8) = pack8(o); *(LAS v4u*)(XM + t * 136 + cg * 8) = raw; }
}
template <bool SCALE> __device__ __forceinline__ void proj_T(const bf16* WT, const LAS bf16* X, LAS bf16* OT, const LAS float* sc, int ft, int lane) {
    const int q = lane >> 4, i = lane & 15;
    bf16x8 af[4];
#pragma unroll
    for (int kk = 0; kk < 4; ++kk) af[kk] = ldg8(WT + (size_t)(ft * 16 + i) * 128 + 8 * q + 32 * kk);
#pragma unroll
    for (int st = 0; st < 4; ++st) { f32x4 acc = (f32x4){0.f, 0.f, 0.f, 0.f};
#pragma unroll
        for (int kk = 0; kk < 4; ++kk) acc = MFMA16(ldl8(X + (st * 16 + i) * 136 + 8 * q + 32 * kk), af[kk], acc);
        if (SCALE) { const f32x4 s4 = *(const LAS f32x4*)(sc + st * 16 + 4 * q); acc = acc * s4; }
        *(LAS v2u*)(OT + (ft * 16 + i) * 72 + st * 16 + 4 * q) = pack4(acc); }
}
__device__ __forceinline__ void proj_R(const bf16* WT, const LAS bf16* X, LAS bf16* O, int ft, int lane) {
    const int q = lane >> 4, i = lane & 15;
    bf16x8 bf[4];
#pragma unroll
    for (int kk = 0; kk < 4; ++kk) bf[kk] = ldg8(WT + (size_t)(ft * 16 + i) * 128 + 8 * q + 32 * kk);
#pragma unroll
    for (int st = 0; st < 4; ++st) { f32x4 acc = (f32x4){0.f, 0.f, 0.f, 0.f};
#pragma unroll
        for (int kk = 0; kk < 4; ++kk) acc = MFMA16(bf[kk], ldl8(X + (st * 16 + i) * 136 + 8 * q + 32 * kk), acc);
        *(LAS v2u*)(O + (st * 16 + i) * 136 + ft * 16 + 4 * q) = pack4(acc); }
}
__device__ __forceinline__ void mlstm_local(const Frame& F, int l, int item) {
    const int c = item & 63, bh = item >> 6, h = bh & 3, b = bh >> 2, lane = F.lane, q = lane >> 4, i = lane & 15;
    LAS bf16* XC = (LAS bf16*)F.lds; LAS bf16* XM = XC + 64 * 136; LAS bf16* EKT = XM + 64 * 136; LAS bf16* VT = EKT + 128 * 72; LAS float* EW = (LAS float*)(VT + 128 * 72);
    float* MS = (float*)(F.ws + WS_MS);
    mlstm_load(F, l, b, h, c, XC, XM);
    if (F.wave == 0) {
        const float* PS = (const float*)(F.ws + WS_PS) + (size_t)(b * SEQ + c * 64 + lane) * 16;
        const float li = *(const GAS float*)(PS + h) + inp(F, 11)[l * 4 + h], lf = logsigmoidf_(*(const GAS float*)(PS + 4 + h) + inp(F, 12)[l * 4 + h]);
        const float bc = wave_incl_sum(lf, lane), bt = __shfl(bc, 63), w = bt - bc + li, ml = wave_maxf(w);
        EW[lane] = __expf(w - ml);
        if (lane == 0) { MS[item] = ml; MS[2048 + item] = bt; }
    }
    __syncthreads();
    const bf16* W = wlayer(F, l);
    proj_T<true>(W + W_K + h * 16384, XC, EKT, EW, F.wave, lane);
    proj_T<false>(W + W_V + h * 16384, XM, VT, EW, F.wave, lane);
    __syncthreads();
    {
        bf16* CT = (bf16*)(F.ws + WS_MC) + (size_t)item * 16384;
        bf16x8 af[2];
#pragma unroll
        for (int kk = 0; kk < 2; ++kk) af[kk] = ldl8(VT + (F.wave * 16 + i) * 72 + 8 * q + 32 * kk);
#pragma unroll
        for (int dt = 0; dt < 8; ++dt) { f32x4 acc = (f32x4){0.f, 0.f, 0.f, 0.f};
#pragma unroll
            for (int kk = 0; kk < 2; ++kk) acc = MFMA16(ldl8(EKT + (dt * 16 + i) * 72 + 8 * q + 32 * kk), af[kk], acc);
            *(GAS v2u*)(CT + (size_t)(F.wave * 16 + i) * 128 + dt * 16 + 4 * q) = pack4(acc); }
        if (F.tid < 128) { float s = 0.f;
#pragma unroll
            for (int j = 0; j < 8; ++j) { const v4u w = *(const LAS v4u*)(EKT + F.tid * 72 + 8 * j); s += (lo16(w.x) + hi16(w.x)) + (lo16(w.y) + hi16(w.y)) + (lo16(w.z) + hi16(w.z)) + (lo16(w.w) + hi16(w.w)); }
            *(GAS float*)((float*)(F.ws + WS_MN) + (size_t)item * 128 + F.tid) = s; }
    }
    __syncthreads();
}
__device__ __forceinline__ void mlstm_out(const Frame& F, int l, int item) {
    const int c = item & 63, bh = item >> 6, h = bh & 3, b = bh >> 2, lane = F.lane, q = lane >> 4, i = lane & 15;
    LAS bf16* XC = (LAS bf16*)F.lds; LAS bf16* XM = XC + 64 * 136; LAS bf16* Q = XM + 64 * 136; LAS bf16* K = Q + 64 * 136; LAS bf16* VT = K + 64 * 136; LAS bf16* SC = VT + 128 * 72;
    LAS float* GV = (LAS float*)(SC + 64 * 72); LAS float* AL = GV + 64; LAS float* EI = AL + 64; LAS float* EM = EI + 64; LAS float* DEN = EM + 64; LAS float* QN = DEN + 64; LAS float* SS = QN + 64;
    const float* MS = (const float*)(F.ws + WS_MS);
    mlstm_load(F, l, b, h, c, XC, XM);
    if (F.wave == 0) {
        const float* PS = (const float*)(F.ws + WS_PS) + (size_t)(b * SEQ + c * 64 + lane) * 16;
        const float li = *(const GAS float*)(PS + h) + inp(F, 11)[l * 4 + h], lf = logsigmoidf_(*(const GAS float*)(PS + 4 + h) + inp(F, 12)[l * 4 + h]);
        const float bc = wave_incl_sum(lf, lane), g = li - bc, pm = wave_incl_max(g, lane), mst = *(const GAS float*)(MS + 4096 + item);
        const float il = bc + mst, mt = fmaxf(il, bc + pm);
        GV[lane] = g; AL[lane] = bc - mt; EI[lane] = __expf(il - mt); EM[lane] = __expf(-mt); DEN[lane] = 0.f; SS[lane] = 0.f;
    }
    __syncthreads();
    const bf16* W = wlayer(F, l);
    proj_R(W + W_Q + h * 16384, XC, Q, F.wave, lane);
    proj_R(W + W_K + h * 16384, XC, K, F.wave, lane);
    proj_T<false>(W + W_V + h * 16384, XM, VT, GV, F.wave, lane);
    __syncthreads();
    {
#pragma unroll
        for (int r2 = 0; r2 < 2; ++r2) { const int tile = F.wave + 8 * r2, tt = tile >> 2, st = tile & 3;
            f32x4 acc = (f32x4){0.f, 0.f, 0.f, 0.f};
            if (st <= tt) {
#pragma unroll
                for (int kk = 0; kk < 4; ++kk) acc = MFMA16(ldl8(K + (st * 16 + i) * 136 + 8 * q + 32 * kk), ldl8(Q + (tt * 16 + i) * 136 + 8 * q + 32 * kk), acc);
                const int t = tt * 16 + i; const float al = AL[t]; const f32x4 g4 = *(const LAS f32x4*)(GV + st * 16 + 4 * q); float rs = 0.f;
#pragma unroll
                for (int r = 0; r < 4; ++r) { const int s = st * 16 + 4 * q + r; const float f = (s <= t) ? __expf(al + g4[r]) : 0.f; acc[r] *= f; rs += acc[r]; }
                rs += __shfl_xor(rs, 16); rs += __shfl_xor(rs, 32);
                if (q == 0) lds_addf(DEN + t, rs);
            }
            *(LAS v2u*)(SC + (tt * 16 + i) * 72 + st * 16 + 4 * q) = pack4(acc); }
        { const int t = F.tid >> 3, part = F.tid & 7; const float* NS = (const float*)(F.ws + WS_MN) + (size_t)item * 128 + part * 16;
          const v4u w0 = *(const LAS v4u*)(Q + t * 136 + part * 16), w1 = *(const LAS v4u*)(Q + t * 136 + part * 16 + 8);
          const f32x4 n0 = *(const GAS f32x4*)NS, n1 = *(const GAS f32x4*)(NS + 4), n2 = *(const GAS f32x4*)(NS + 8), n3 = *(const GAS f32x4*)(NS + 12);
          float s = lo16(w0.x) * n0[0] + hi16(w0.x) * n0[1] + lo16(w0.y) * n0[2] + hi16(w0.y) * n0[3] + lo16(w0.z) * n1[0] + hi16(w0.z) * n1[1] + lo16(w0.w) * n1[2] + hi16(w0.w) * n1[3]
                  + lo16(w1.x) * n2[0] + hi16(w1.x) * n2[1] + lo16(w1.y) * n2[2] + hi16(w1.y) * n2[3] + lo16(w1.z) * n3[0] + hi16(w1.z) * n3[1] + lo16(w1.w) * n3[2] + hi16(w1.w) * n3[3];
          s += __shfl_xor(s, 1); s += __shfl_xor(s, 2); s += __shfl_xor(s, 4);
          if (part == 0) QN[t] = s; }
    }
    __syncthreads();
    f32x4 hv[4];
    bf16* Pm = (bf16*)(F.ws + WS_P) + (size_t)(b * SEQ + c * 64) * NP + PC_OM + h * 128;
    {
        const bf16* CT = (const bf16*)(F.ws + WS_MC) + (size_t)item * 16384;
        const int e0 = F.wave * 16;
        bf16x8 vf[2], cf[4];
#pragma unroll
        for (int kk = 0; kk < 2; ++kk) vf[kk] = ldl8(VT + (e0 + i) * 72 + 8 * q + 32 * kk);
#pragma unroll
        for (int kk = 0; kk < 4; ++kk) cf[kk] = ldg8(CT + (size_t)(e0 + i) * 128 + 8 * q + 32 * kk);
#pragma unroll
        for (int tt = 0; tt < 4; ++tt) { f32x4 a1 = (f32x4){0.f, 0.f, 0.f, 0.f}, a2 = (f32x4){0.f, 0.f, 0.f, 0.f};
#pragma unroll
            for (int kk = 0; kk < 2; ++kk) a1 = MFMA16(vf[kk], ldl8(SC + (tt * 16 + i) * 72 + 8 * q + 32 * kk), a1);
#pragma unroll
            for (int kk = 0; kk < 4; ++kk) a2 = MFMA16(cf[kk], ldl8(Q + (tt * 16 + i) * 136 + 8 * q + 32 * kk), a2);
            const int t = tt * 16 + i; const float ei = EI[t], den = DEN[t] + ei * QN[t], inv = 1.0f / fmaxf(fabsf(den), EM[t]);
            const v2u ow = *(const GAS v2u*)(Pm + (size_t)t * NP + e0 + 4 * q);
            f32x4 o; o[0] = sigmoidf_(lo16(ow.x)); o[1] = sigmoidf_(hi16(ow.x)); o[2] = sigmoidf_(lo16(ow.y)); o[3] = sigmoidf_(hi16(ow.y));
            float ss = 0.f;
#pragma unroll
            for (int r = 0; r < 4; ++r) { const float v = (a1[r] + ei * a2[r]) * inv * o[r]; hv[tt][r] = v; ss += v * v; }
            ss += __shfl_xor(ss, 16); ss += __shfl_xor(ss, 32);
            if (q == 0) lds_addf(SS + t, ss); }
    }
    __syncthreads();
    { const f32x4 gn = *(const GAS f32x4*)(inp(F, 13) + l * 512 + h * 128 + F.wave * 16 + 4 * q);
#pragma unroll
      for (int tt = 0; tt < 4; ++tt) { const int t = tt * 16 + i; const float rn = 1.0f / sqrtf(SS[t] * (1.0f / 128.0f) + EPS);
          *(GAS v2u*)(Pm + (size_t)t * NP + F.wave * 16 + 4 * q) = pack4(hv[tt] * rn * gn); } }
    __syncthreads();
}

__device__ __forceinline__ void ssd_gates(const Frame& F, int l, int b, int c, int g, LAS float* DT, LAS float* ACUM, float& dt, float& acum, float& alast) {
    const int hh = F.wave, h = 4 * g + hh, lane = F.lane;
    const float raw = *(const GAS float*)((const float*)(F.ws + WS_PS) + (size_t)(b * SEQ + c * 64 + lane) * 16 + 8 + h);
    dt = softplusf_(raw + inp(F, 23)[l * 8 + h]);
    const float a = -dt * __expf(inp(F, 24)[l * 8 + h]);
    acum = wave_incl_sum(a, lane); alast = __shfl(acum, 63);
    DT[lane * 4 + hh] = dt; ACUM[lane * 4 + hh] = acum;
}
__device__ __forceinline__ void ssd_local(const Frame& F, int l, int item) {
    const int g = item & 1, bc = item >> 1, c = bc & 63, b = bc >> 6, lane = F.lane, q = lane >> 4, i = lane & 15;
    LAS bf16* XWT = (LAS bf16*)F.lds; LAS bf16* BMT = XWT + 256 * 72; LAS float* DTW = (LAS float*)(BMT + 128 * 72); LAS float* ACUM = DTW + 256;
    float* DEC = (float*)(F.ws + WS_MS) + 8192;
    if (F.wave < 4) { float dt, acum, alast; ssd_gates(F, l, b, c, g, DTW, ACUM, dt, acum, alast);
        DTW[lane * 4 + F.wave] = dt * __expf(alast - acum);
        if (lane == 63) *(GAS float*)(DEC + ((size_t)(b * 8 + 4 * g + F.wave) * 64 + c)) = __expf(alast); }
    __syncthreads();
    const bf16* P = (const bf16*)(F.ws + WS_P); const float* cw = inp(F, 21) + (size_t)l * 4 * 1024; const float* cb = inp(F, 22) + l * 1024;
#pragma unroll 1
    for (int it = 0; it < 6; ++it) { const int u = F.tid + NTHR * it, tb = u / 384, col = u - tb * 384;
        const int ch = col < 256 ? g * 256 + col : 512 + g * 128 + (col - 256), pos0 = c * 64 + tb * 8;
        float o[8]; conv_t8<true>(P + (size_t)(b * SEQ + pos0) * NP + PC_XBC + ch, pos0, cw + ch, 1024, cb[ch], o);
        if (col < 256) { const int hh = col >> 6;
#pragma unroll
            for (int j = 0; j < 8; ++j) o[j] *= DTW[(tb * 8 + j) * 4 + hh];
            *(LAS v4u*)(XWT + col * 72 + tb * 8) = pack8(o); }
        else *(LAS v4u*)(BMT + (col - 256) * 72 + tb * 8) = pack8(o); }
    __syncthreads();
    {
        bf16* SST = (bf16*)(F.ws + WS_SS);
#pragma unroll
        for (int mi = 0; mi < 2; ++mi) { const int mt = 2 * F.wave + mi, hp = mt * 16 + i, hh = hp >> 6, p = hp & 63;
            bf16x8 af[2];
#pragma unroll
            for (int kk = 0; kk < 2; ++kk) af[kk] = ldl8(XWT + hp * 72 + 8 * q + 32 * kk);
            bf16* dst = SST + ((size_t)((b * 8 + 4 * g + hh) * 64 + c)) * 8192 + (size_t)p * 128;
#pragma unroll
            for (int nt = 0; nt < 8; ++nt) { f32x4 acc = (f32x4){0.f, 0.f, 0.f, 0.f};
#pragma unroll
                for (int kk = 0; kk < 2; ++kk) acc = MFMA16(ldl8(BMT + (nt * 16 + i) * 72 + 8 * q + 32 * kk), af[kk], acc);
                *(GAS v2u*)(dst + nt * 16 + 4 * q) = pack4(acc); } }
    }
    __syncthreads();
}
__device__ __forceinline__ void ssd_out(const Frame& F, int l, int item) {
    const int c = item & 63, b = item >> 6, lane = F.lane, q = lane >> 4, i = lane & 15;
    LAS bf16* CM = (LAS bf16*)F.lds; LAS bf16* BM = CM + 64 * 136; LAS bf16* XDT = BM + 64 * 136; LAS bf16* CB = XDT + 256 * 72;
    LAS float* DT = (LAS float*)(CB + 4 * 64 * 72); LAS float* ACUM = DT + 256; LAS float* SS = ACUM + 256;
    const bf16* P = (const bf16*)(F.ws + WS_P); const float* cw = inp(F, 21) + (size_t)l * 4 * 1024; const float* cb = inp(F, 22) + l * 1024;
    bf16* Pz = (bf16*)(F.ws + WS_P) + (size_t)(b * SEQ + c * 64) * NP + PC_ZS;
    if (F.tid < 64) SS[F.tid] = 0.f;
#pragma unroll
    for (int g = 0; g < 2; ++g) {
        if (F.wave < 4) { float dt, acum, alast; ssd_gates(F, l, b, c, g, DT, ACUM, dt, acum, alast); }
        __syncthreads();
#pragma unroll 1
        for (int it = 0; it < 4; ++it) { const int u = F.tid + NTHR * it;
            if (u < 1024) { const int t = u >> 4, cg = u & 15, pos = c * 64 + t, ch = 768 + g * 128 + cg * 8; float o[8]; v4u raw;
                conv8<true>(P + (size_t)(b * SEQ + pos) * NP + PC_XBC + ch, pos, cw + ch, 1024, cb + ch, o, raw); *(LAS v4u*)(CM + t * 136 + cg * 8) = pack8(o); }
            else { const int u2 = u - 1024, t = u2 >> 4, cg = u2 & 15, pos = c * 64 + t, ch = 512 + g * 128 + cg * 8; float o[8]; v4u raw;
                conv8<true>(P + (size_t)(b * SEQ + pos) * NP + PC_XBC + ch, pos, cw + ch, 1024, cb + ch, o, raw); *(LAS v4u*)(BM + t * 136 + cg * 8) = pack8(o); } }
#pragma unroll 1
        for (int it = 0; it < 4; ++it) { const int u = F.tid + NTHR * it, tb = u >> 8, col = u & 255, ch = g * 256 + col, pos0 = c * 64 + tb * 8, hh = col >> 6;
            float o[8]; conv_t8<true>(P + (size_t)(b * SEQ + pos0) * NP + PC_XBC + ch, pos0, cw + ch, 1024, cb[ch], o);
#pragma unroll
            for (int j = 0; j < 8; ++j) o[j] *= DT[(tb * 8 + j) * 4 + hh];
            *(LAS v4u*)(XDT + col * 72 + tb * 8) = pack8(o); }
        __syncthreads();
        {
#pragma unroll
            for (int r2 = 0; r2 < 2; ++r2) { const int tile = F.wave + 8 * r2, lt = tile >> 2, st = tile & 3;
                f32x4 acc = (f32x4){0.f, 0.f, 0.f, 0.f};
                if (st <= lt) {
#pragma unroll
                    for (int kk = 0; kk < 4; ++kk) acc = MFMA16(ldl8(BM + (st * 16 + i) * 136 + 8 * q + 32 * kk), ldl8(CM + (lt * 16 + i) * 136 + 8 * q + 32 * kk), acc); }
                const int tl = lt * 16 + i;
#pragma unroll
                for (int hh = 0; hh < 4; ++hh) { f32x4 v = (f32x4){0.f, 0.f, 0.f, 0.f};
                    if (st <= lt) { const float al = ACUM[tl * 4 + hh], dsk = inp(F, 25)[l * 8 + 4 * g + hh] / DT[tl * 4 + hh];
#pragma unroll
                        for (int r = 0; r < 4; ++r) { const int s = st * 16 + 4 * q + r; float f = (s <= tl) ? acc[r] * __expf(al - ACUM[s * 4 + hh]) : 0.f; if (s == tl) f += dsk; v[r] = f; } }
                    *(LAS v2u*)(CB + hh * 64 * 72 + tl * 72 + st * 16 + 4 * q) = pack4(v); } }
        }
        __syncthreads();
        {
            const int hh = F.wave >> 1, h = 4 * g + hh;
            const bf16* SST = (const bf16*)(F.ws + WS_SS) + ((size_t)((b * 8 + h) * 64 + c)) * 8192;
#pragma unroll
            for (int pi = 0; pi < 2; ++pi) { const int pt = 2 * (F.wave & 1) + pi;
                bf16x8 xf[2], sf[4];
#pragma unroll
                for (int kk = 0; kk < 2; ++kk) xf[kk] = ldl8(XDT + (hh * 64 + pt * 16 + i) * 72 + 8 * q + 32 * kk);
#pragma unroll
                for (int kk = 0; kk < 4; ++kk) sf[kk] = ldg8(SST + (size_t)(pt * 16 + i) * 128 + 8 * q + 32 * kk);
#pragma unroll
                for (int lt = 0; lt < 4; ++lt) { f32x4 a1 = (f32x4){0.f, 0.f, 0.f, 0.f}, a2 = (f32x4){0.f, 0.f, 0.f, 0.f};
#pragma unroll
                    for (int kk = 0; kk < 2; ++kk) a1 = MFMA16(xf[kk], ldl8(CB + hh * 64 * 72 + (lt * 16 + i) * 72 + 8 * q + 32 * kk), a1);
#pragma unroll
                    for (int kk = 0; kk < 4; ++kk) a2 = MFMA16(sf[kk], ldl8(CM + (lt * 16 + i) * 136 + 8 * q + 32 * kk), a2);
                    const int tl = lt * 16 + i; const float ea = __expf(ACUM[tl * 4 + hh]);
                    const v2u zw = *(const GAS v2u*)(Pz + (size_t)tl * NP + h * 64 + pt * 16 + 4 * q);
                    f32x4 z; z[0] = siluf_(lo16(zw.x)); z[1] = siluf_(hi16(zw.x)); z[2] = siluf_(lo16(zw.y)); z[3] = siluf_(hi16(zw.y));
                    float ss = 0.f; f32x4 yo;
#pragma unroll
                    for (int r = 0; r < 4; ++r) { const float v = (a1[r] + ea * a2[r]) * z[r]; yo[r] = v; ss += v * v; }
                    *(GAS v2u*)(Pz + (size_t)tl * NP + h * 64 + pt * 16 + 4 * q) = pack4(yo);
                    ss += __shfl_xor(ss, 16); ss += __shfl_xor(ss, 32);
                    if (q == 0) lds_addf(SS + tl, ss); } }
        }
        __syncthreads();
    }
    {
#pragma unroll
        for (int g = 0; g < 2; ++g) { const int hh = F.wave >> 1, h = 4 * g + hh;
#pragma unroll
            for (int pi = 0; pi < 2; ++pi) { const int pt = 2 * (F.wave & 1) + pi; const f32x4 gn = *(const GAS f32x4*)(inp(F, 26) + l * 512 + h * 64 + pt * 16 + 4 * q);
#pragma unroll
                for (int lt = 0; lt < 4; ++lt) { const int tl = lt * 16 + i; const float rn = 1.0f / sqrtf(SS[tl] * (1.0f / 512.0f) + EPS);
                    GAS v2u* dp = (GAS v2u*)(Pz + (size_t)tl * NP + h * 64 + pt * 16 + 4 * q); const v2u w = *dp;
                    f32x4 y; y[0] = lo16(w.x); y[1] = hi16(w.x); y[2] = lo16(w.y); y[3] = hi16(w.y);
                    *dp = pack4(y * rn * gn); } } }
    }
    __syncthreads();
}

template <bool OUT> __device__ __forceinline__ void rglru_item(const Frame& F, int l, int item) {
    const int half = item & 1, bc = item >> 1, c = bc & 63, b = bc >> 6, lane = F.lane, q = lane >> 4, i = lane & 15, ch0 = half * 256;
    LAS bf16* XCV = (LAS bf16*)F.lds; LAS bf16* LA = XCV + 64 * 264; LAS bf16* GI = LA + 64 * 264; LAS float* SP = (LAS float*)(GI + 64 * 264);
    const bf16* P = (const bf16*)(F.ws + WS_P); const float* cw = inp(F, 14) + (size_t)l * 4 * 512 + ch0; const float* cb = inp(F, 15) + l * 512 + ch0;
#pragma unroll 1
    for (int it = 0; it < 4; ++it) { const int u = F.tid + NTHR * it, t = u >> 5, cg = u & 31, pos = c * 64 + t; float o[8]; v4u raw;
        conv8<false>(P + (size_t)(b * SEQ + pos) * NP + PC_XR + ch0 + cg * 8, pos, cw + cg * 8, 512, cb + cg * 8, o, raw); *(LAS v4u*)(XCV + t * 264 + cg * 8) = pack8(o); }
    if (F.tid < 256) SP[F.tid] = softplusf_(-inp(F, 20)[l * 512 + ch0 + F.tid]);
    __syncthreads();
    {
        const int gate = F.wave >> 2, blk = F.wave & 3;
        const bf16* WT = wlayer(F, l) + (gate == 0 ? W_A : W_X) + (size_t)(half * 4 + blk) * 4096;
        const float* bias = (gate == 0 ? inp(F, 17) : inp(F, 19)) + l * 512 + ch0 + blk * 64;
#pragma unroll
        for (int et = 0; et < 4; ++et) { bf16x8 bf[2];
#pragma unroll
            for (int kk = 0; kk < 2; ++kk) bf[kk] = ldg8(WT + (size_t)(et * 16 + i) * 64 + 8 * q + 32 * kk);
            const f32x4 b4 = *(const GAS f32x4*)(bias + et * 16 + 4 * q); const int chl = blk * 64 + et * 16 + 4 * q;
            const f32x4 sp4 = *(const LAS f32x4*)(SP + chl);
#pragma unroll
            for (int tt = 0; tt < 4; ++tt) { f32x4 acc = (f32x4){0.f, 0.f, 0.f, 0.f};
#pragma unroll
                for (int kk = 0; kk < 2; ++kk) acc = MFMA16(bf[kk], ldl8(XCV + (tt * 16 + i) * 264 + blk * 64 + 8 * q + 32 * kk), acc);
                const int t = tt * 16 + i; f32x4 o;
                if (gate == 0) {
#pragma unroll
                    for (int r = 0; r < 4; ++r) o[r] = -8.0f * sigmoidf_(acc[r] + b4[r]) * sp4[r];
                    *(LAS v2u*)(LA + t * 264 + chl) = pack4(o);
                } else { const v2u xw = *(const LAS v2u*)(XCV + t * 264 + chl);
                    o[0] = sigmoidf_(acc[0] + b4[0]) * lo16(xw.x); o[1] = sigmoidf_(acc[1] + b4[1]) * hi16(xw.x); o[2] = sigmoidf_(acc[2] + b4[2]) * lo16(xw.y); o[3] = sigmoidf_(acc[3] + b4[3]) * hi16(xw.y);
                    *(LAS v2u*)(GI + t * 264 + chl) = pack4(o); } } }
    }
    __syncthreads();
    float* RG = (float*)(F.ws + WS_RG);
    if (F.tid < 256) { const int ch = F.tid;
        float hs = OUT ? *(const GAS float*)(RG + 2 * 262144 + (size_t)item * 256 + ch) : 0.f, ap = 1.0f;
        bf16* Py = (bf16*)(F.ws + WS_P) + (size_t)(b * SEQ + c * 64) * NP + PC_YR + ch0 + ch;
#pragma unroll 4
        for (int t = 0; t < 64; ++t) { const float la = bf2f((unsigned)LA[t * 264 + ch]), gi = bf2f((unsigned)GI[t * 264 + ch]);
            const float a = __expf(la), mult = sqrtf(-expm1f(2.0f * la));
            hs = a * hs + mult * gi; ap *= a;
            if (OUT) { const float y = bf2f((unsigned)*(const GAS bf16*)(Py + (size_t)t * NP)); *(GAS bf16*)(Py + (size_t)t * NP) = (bf16)f2bf(hs * pg8::gelu_tanh(y)); } }
        if (!OUT) { *(GAS float*)(RG + (size_t)item * 256 + ch) = ap; *(GAS float*)(RG + 262144 + (size_t)item * 256 + ch) = hs; } }
    __syncthreads();
}

__device__ __forceinline__ void scans(const Frame& F) {
    const int gt = F.vcu * NTHR + F.tid, NT = F.G * NTHR;
    float* MS = (float*)(F.ws + WS_MS);
    for (int job = gt; job < 32 * 2048; job += NT) { const int sq = job >> 11, grp = job & 2047;
        bf16* p = (bf16*)(F.ws + WS_MC) + (size_t)sq * 64 * 16384 + grp * 8;
        float st[8]; float m = 0.f;
#pragma unroll
        for (int j = 0; j < 8; ++j) st[j] = 0.f;
#pragma unroll 1
        for (int c0 = 0; c0 < 64; c0 += 8) { v4u v[8];
#pragma unroll
            for (int k = 0; k < 8; ++k) v[k] = *(const GAS v4u*)(p + (size_t)(c0 + k) * 16384);
#pragma unroll
            for (int k = 0; k < 8; ++k) { const int it = sq * 64 + c0 + k; const float ml = *(const GAS float*)(MS + it), bt = *(const GAS float*)(MS + 2048 + it);
                const float mn = fmaxf(bt + m, ml), sp = __expf(bt + m - mn), sl = __expf(ml - mn);
                if (grp == 0) *(GAS float*)(MS + 4096 + it) = m;
                v4u o; o.x = pk2(st[0], st[1]); o.y = pk2(st[2], st[3]); o.z = pk2(st[4], st[5]); o.w = pk2(st[6], st[7]);
                *(GAS v4u*)(p + (size_t)(c0 + k) * 16384) = o;
                st[0] = sp * st[0] + sl * lo16(v[k].x); st[1] = sp * st[1] + sl * hi16(v[k].x); st[2] = sp * st[2] + sl * lo16(v[k].y); st[3] = sp * st[3] + sl * hi16(v[k].y);
                st[4] = sp * st[4] + sl * lo16(v[k].z); st[5] = sp * st[5] + sl * hi16(v[k].z); st[6] = sp * st[6] + sl * lo16(v[k].w); st[7] = sp * st[7] + sl * hi16(v[k].w);
                m = mn; } } }
    for (int job = gt; job < 64 * 1024; job += NT) { const int sq = job >> 10, grp = job & 1023;
        bf16* p = (bf16*)(F.ws + WS_SS) + (size_t)sq * 64 * 8192 + grp * 8;
        float st[8];
#pragma unroll
        for (int j = 0; j < 8; ++j) st[j] = 0.f;
#pragma unroll 1
        for (int c0 = 0; c0 < 64; c0 += 8) { v4u v[8];
#pragma unroll
            for (int k = 0; k < 8; ++k) v[k] = *(const GAS v4u*)(p + (size_t)(c0 + k) * 8192);
#pragma unroll
            for (int k = 0; k < 8; ++k) { const float dc = *(const GAS float*)(MS + 8192 + sq * 64 + c0 + k);
                v4u o; o.x = pk2(st[0], st[1]); o.y = pk2(st[2], st[3]); o.z = pk2(st[4], st[5]); o.w = pk2(st[6], st[7]);
                *(GAS v4u*)(p + (size_t)(c0 + k) * 8192) = o;
                st[0] = dc * st[0] + lo16(v[k].x); st[1] = dc * st[1] + hi16(v[k].x); st[2] = dc * st[2] + lo16(v[k].y); st[3] = dc * st[3] + hi16(v[k].y);
                st[4] = dc * st[4] + lo16(v[k].z); st[5] = dc * st[5] + hi16(v[k].z); st[6] = dc * st[6] + lo16(v[k].w); st[7] = dc * st[7] + hi16(v[k].w); } } }
    for (int job = gt; job < 32 * 128; job += NT) { const int sq = job >> 7, e = job & 127; float* p = (float*)(F.ws + WS_MN) + (size_t)sq * 64 * 128 + e; float st = 0.f, m = 0.f;
#pragma unroll 1
        for (int c = 0; c < 64; ++c) { const int it = sq * 64 + c; const float ml = *(const GAS float*)(MS + it), bt = *(const GAS float*)(MS + 2048 + it), mn = fmaxf(bt + m, ml), sp = __expf(bt + m - mn), sl = __expf(ml - mn);
            const float v = *(const GAS float*)(p + c * 128); *(GAS float*)(p + c * 128) = st; st = sp * st + sl * v; m = mn; } }
    for (int job = gt; job < 8 * 512; job += NT) { const int b = job >> 9, half = (job >> 8) & 1, ch = job & 255; float* RG = (float*)(F.ws + WS_RG); float h = 0.f;
#pragma unroll 1
        for (int c = 0; c < 64; ++c) { const size_t o = (size_t)(((b * 64 + c) * 2 + half)) * 256 + ch; const float a = *(const GAS float*)(RG + o), u = *(const GAS float*)(RG + 262144 + o);
            *(GAS float*)(RG + 2 * 262144 + o) = h; h = a * h + u; } }
}

__device__ __forceinline__ void rms_update(const Frame& F, const float* xold, float* xnew, const float* g, bool write_xn) {
    const int gw = F.vcu * NWAVES + F.wave, NGW = F.G * NWAVES;
    const float* Y = (const float*)(F.ws + WS_Y); bf16* XN = (bf16*)(F.ws + WS_XN);
    f32x4 gv[4];
#pragma unroll
    for (int j = 0; j < 4; ++j) gv[j] = *((const GAS f32x4*)g + F.lane + 64 * j);
    for (int m = gw; m < TOK; m += NGW) {
        const GAS f32x4* yr = (const GAS f32x4*)(Y + (size_t)m * DM) + F.lane; const GAS f32x4* xr = (const GAS f32x4*)(xold + (size_t)m * DM) + F.lane;
        f32x4 y[4], x[4]; float s = 0.f;
#pragma unroll
        for (int j = 0; j < 4; ++j) { y[j] = yr[64 * j]; x[j] = xr[64 * j]; s += (y[j][0] * y[j][0] + y[j][1] * y[j][1]) + (y[j][2] * y[j][2] + y[j][3] * y[j][3]); }
        const float r1 = 1.0f / sqrtf(wave_sum(s) * (1.0f / DM) + EPS); float s2 = 0.f;
#pragma unroll
        for (int j = 0; j < 4; ++j) { x[j] = x[j] + y[j] * r1 * gv[j]; s2 += (x[j][0] * x[j][0] + x[j][1] * x[j][1]) + (x[j][2] * x[j][2] + x[j][3] * x[j][3]); }
        GAS f32x4* xo = (GAS f32x4*)(xnew + (size_t)m * DM) + F.lane;
#pragma unroll
        for (int j = 0; j < 4; ++j) xo[64 * j] = x[j];
        if (write_xn) { const float r2 = 1.0f / sqrtf(wave_sum(s2) * (1.0f / DM) + EPS); GAS v2u* o8 = (GAS v2u*)(XN + (size_t)m * DM) + F.lane;
#pragma unroll
            for (int j = 0; j < 4; ++j) { v2u w; w.x = pk2(x[j][0] * r2, x[j][1] * r2); w.y = pk2(x[j][2] * r2, x[j][3] * r2); o8[64 * j] = w; } }
    }
}
__device__ __forceinline__ void ffn_fixup(const Frame& F, int l) {
    const int gt = F.vcu * NTHR + F.tid, NT = F.G * NTHR;
    const float* UH = (const float*)(F.ws + WS_HALO); const float* UF = UH + (size_t)128 * 2 * 5632; bf16* ACT = (bf16*)(F.ws + WS_P);
    const float* cw = inp(F, 29) + (size_t)l * 3 * 5632; const float* cb = inp(F, 30) + l * 5632;
    for (int job = gt; job < 128 * 2816; job += NT) { const int pm = job / 2816, j = job - pm * 2816;
        float o[2];
#pragma unroll
        for (int gv = 0; gv < 2; ++gv) { const int col = gv * 2816 + j;
            const float u0 = *(const GAS float*)(UF + ((size_t)pm * 2) * 5632 + col), u1 = *(const GAS float*)(UF + ((size_t)pm * 2 + 1) * 5632 + col);
            float h0 = 0.f, h1 = 0.f; if (pm & 15) { h0 = *(const GAS float*)(UH + ((size_t)(pm - 1) * 2) * 5632 + col); h1 = *(const GAS float*)(UH + ((size_t)(pm - 1) * 2 + 1) * 5632 + col); }
            const float w0 = cw[col], w1 = cw[5632 + col], w2 = cw[2 * 5632 + col], bb = cb[col];
            const float r0 = bb + w0 * h0 + w1 * h1 + w2 * u0, r1 = bb + w0 * h1 + w1 * u0 + w2 * u1;
            if (gv == 0) { o[0] = pg8::gelu_tanh(r0); o[1] = pg8::gelu_tanh(r1); } else { o[0] *= r0; o[1] *= r1; } }
        *(GAS bf16*)(ACT + (size_t)(pm * 256) * DFF + j) = (bf16)f2bf(o[0]); *(GAS bf16*)(ACT + (size_t)(pm * 256 + 1) * DFF + j) = (bf16)f2bf(o[1]); }
}

__global__ void __launch_bounds__(NWAVES * 64, 2) hymba_fwd(Args args) {
    extern __shared__ __attribute__((aligned(16))) unsigned char lds[];
    Frame F;
    F.lds = (LAS unsigned char*)lds;
    F.MISC = (volatile LAS unsigned*)(F.lds + MISC_OFF);
    F.tid = threadIdx.x; F.lane = F.tid & 63; F.wave = __builtin_amdgcn_readfirstlane(F.tid >> 6);
    F.G = gridDim.x; { const int bx = blockIdx.x; F.vcu = (F.G % 8 == 0) ? (bx % 8) * (F.G / 8) + bx / 8 : bx; }
    F.ws = args.ws; F.ctl = (gu32*)(args.ws + WS_CTL);
    for (int u = F.tid; u < (LDS_BYTES - LDSCTL_OFF) / 4; u += NWAVES * 64) ((LAS unsigned*)(F.lds + LDSCTL_OFF))[u] = 0u;
    __syncthreads();
    {
        volatile LAS unsigned long long* pt = (volatile LAS unsigned long long*)(F.lds + PTR_OFF);
#pragma unroll
        for (int k = 0; k < 32; ++k) if (F.tid == k) pt[k] = (unsigned long long)args.in[k];
    }
    __syncthreads();
    XcdBarrier bar; bar.bar = (unsigned*)(F.ctl + CW_BAR); bar.x = 0; bar.st = nullptr;
    if (!MK_PER_PHASE) bar = xcd_barrier_post((unsigned*)(F.ctl + CW_BAR), F.MISC + 8);
    const int lo = MK_PER_PHASE ? args.ph_lo : 0, hi = MK_PER_PHASE ? args.ph_hi : NPHASES;
    const Frame F0 = F;
#define FRESH() do { int t_ = threadIdx.x; asm volatile("" : "+v"(t_)); F = F0; asm volatile("" : "+s"(F.ws)); F.tid = t_; F.lane = t_ & 63; F.wave = __builtin_amdgcn_readfirstlane(t_ >> 6); } while (0)
#ifndef SKIPMASK
#define SKIPMASK 0
#endif
#define IN(k) (lo <= (k) && (k) < hi)
#define ON(b) (!((SKIPMASK >> (b)) & 1))
#define SEAM(k) do { if (!MK_PER_PHASE && IN(k) && IN((k) + 1)) { XcdBarrier b_ = bar; asm volatile("" : "+s"(b_.bar), "+s"(b_.x)); xcd_barrier(b_); } } while (0)

    if (IN(0)) { FRESH(); if (ON(0)) p0_prologue(F); SEAM(0); }

#pragma unroll 1
    for (int l = 0; l < DEPTH; ++l) {
        const int pb = 1 + 10 * l;
        const bf16* W = wlayer(F, l);
        bf16* XN = (bf16*)(F.ws + WS_XN); bf16* P = (bf16*)(F.ws + WS_P); float* Y = (float*)(F.ws + WS_Y);
        if (IN(pb + 0)) {
            pg8::Gemm g{XN, W + W_IN, TOK, NP, DM, DM}; pg8::StaticOrder S; S.init(TOK, NP, F.G, (int)blockIdx.x);
            pg8::EpiBf16P E{P, NP};
            if (ON(1)) pg8::gemm_phase<pg8::EpiBf16P, pg8::StaticOrder, PG8_ALIGN, PG8_SP2>(F.lds + RING_OFF, g, S, E);
            FRESH(); if (ON(2)) small_cols(F, l);
            SEAM(pb + 0);
        }
        if (IN(pb + 1)) {
#pragma unroll 1
            for (int it = F.vcu; it < 2048; it += F.G) { FRESH(); if (ON(3)) mlstm_local(F, l, it); }
#pragma unroll 1
            for (int it = F.vcu; it < 1024; it += F.G) { FRESH(); if (ON(4)) ssd_local(F, l, it); }
#pragma unroll 1
            for (int it = F.vcu; it < 1024; it += F.G) { FRESH(); if (ON(5)) rglru_item<false>(F, l, it); }
            SEAM(pb + 1);
        }
        if (IN(pb + 2)) { FRESH(); if (ON(6)) scans(F); SEAM(pb + 2); }
        if (IN(pb + 3)) {
#pragma unroll 1
            for (int it = F.vcu; it < 2048; it += F.G) { FRESH(); if (ON(7)) mlstm_out(F, l, it); }
#pragma unroll 1
            for (int it = F.vcu; it < 512; it += F.G) { FRESH(); if (ON(8)) ssd_out(F, l, it); }
#pragma unroll 1
            for (int it = F.vcu; it < 1024; it += F.G) { FRESH(); if (ON(9)) rglru_item<true>(F, l, it); }
            SEAM(pb + 3);
        }
        if (IN(pb + 4)) {
            pg8::Gemm g{P + PC_OM, W + W_OUT, TOK, DM, KMIX, NP}; pg8::StaticOrder S; S.init(TOK, DM, F.G, (int)blockIdx.x);
            pg8::EpiF32 E{Y, DM};
            if (ON(10)) pg8::gemm_phase<pg8::EpiF32, pg8::StaticOrder, PG8_ALIGN, PG8_SP2>(F.lds + RING_OFF, g, S, E);
            SEAM(pb + 4);
        }
        if (IN(pb + 5)) { FRESH(); if (ON(11)) rms_update(F, l == 0 ? inp(F, 0) : args.out, args.out, inp(F, 2) + l * DM, true); SEAM(pb + 5); }
        if (IN(pb + 6)) {
            pg8::Gemm g{XN, W + W_UP, TOK, NUP, DM, DM}; pg8::StaticOrder S; S.init(TOK, NUP, F.G, (int)blockIdx.x);
            pg8::EpiConv E{P, inp(F, 29) + (size_t)l * 3 * NUP, inp(F, 30) + l * NUP, (float*)(F.ws + WS_HALO), (float*)(F.ws + WS_HALO) + (size_t)128 * 2 * NUP, (LAS float*)(F.lds + EPI_OFF)};
            if (ON(12)) pg8::gemm_phase<pg8::EpiConv, pg8::StaticOrder, true, PG8_SP2>(F.lds + RING_OFF, g, S, E);
            SEAM(pb + 6);
        }
        if (IN(pb + 7)) { FRESH(); if (ON(13)) ffn_fixup(F, l); SEAM(pb + 7); }
        if (IN(pb + 8)) {
            pg8::Gemm g{P, W + W_DN, TOK, DM, DFF, DFF}; pg8::StaticOrder S; S.init(TOK, DM, F.G, (int)blockIdx.x);
            pg8::EpiF32 E{Y, DM};
            if (ON(14)) pg8::gemm_phase<pg8::EpiF32, pg8::StaticOrder, PG8_ALIGN, PG8_SP2>(F.lds + RING_OFF, g, S, E);
            SEAM(pb + 8);
        }
        if (IN(pb + 9)) { FRESH(); if (ON(15)) rms_update(F, args.out, args.out, inp(F, 4) + l * DM, l + 1 < DEPTH); SEAM(pb + 9); }
    }
#undef IN
#undef SEAM
}

extern "C" void kernel_launch(void* const* d_in, const int* in_sizes, int n_in, void* d_out, int out_size, void* d_ws, size_t ws_size, hipStream_t stream) {
    static int grid = 0;
    if (grid == 0) {
        if (n_in != 32 || in_sizes[0] != TOK * DM || out_size != TOK * DM || ws_size < WS_END) { fprintf(stderr, "kernel_launch: unexpected shapes: n_in %d in0 %d out %d ws %zu (need %zu)\n", n_in, n_in > 0 ? in_sizes[0] : -1, out_size, ws_size, (size_t)WS_END); grid = -1; return; }
        int dev = 0, cus = 0, per_cu = 0;
        if (hipGetDevice(&dev) != hipSuccess || hipDeviceGetAttribute(&cus, hipDeviceAttributeMultiprocessorCount, dev) != hipSuccess) { grid = -1; return; }
        if (hipFuncSetAttribute((const void*)hymba_fwd, hipFuncAttributeMaxDynamicSharedMemorySize, LDS_BYTES) != hipSuccess) { fprintf(stderr, "kernel_launch: hipFuncSetAttribute failed\n"); grid = -1; return; }
        if (hipOccupancyMaxActiveBlocksPerMultiprocessor(&per_cu, (const void*)hymba_fwd, NWAVES * 64, LDS_BYTES) != hipSuccess || per_cu < 1) fprintf(stderr, "kernel_launch: occupancy query says %d\n", per_cu);
        (void)hipGetLastError();
        grid = cus;
        if (grid != 256) fprintf(stderr, "kernel_launch: %d CUs (built for 256)\n", grid);
    }
    if (grid < 0) return;
    if (hipMemsetAsync((char*)d_ws + WS_CTL, 0, CTL_ZERO_BYTES, stream) != hipSuccess) { fprintf(stderr, "kernel_launch: memset failed\n"); return; }
    Args a{};
    for (int i = 0; i < 32; ++i) a.in[i] = (const float*)d_in[i];
    a.out = (float*)d_out; a.ws = (unsigned char*)d_ws;
#if MK_PER_PHASE
    for (int p = 0; p < NPHASES; ++p) { a.ph_lo = p; a.ph_hi = p + 1; hipLaunchKernelGGL(hymba_fwd, dim3(grid), dim3(NWAVES * 64), LDS_BYTES, stream, a); }
#else
    a.ph_lo = 0; a.ph_hi = NPHASES;
    hipLaunchKernelGGL(hymba_fwd, dim3(grid), dim3(NWAVES * 64), LDS_BYTES, stream, a);
#endif
    const hipError_t le = hipPeekAtLastError();
    if (le != hipSuccess) fprintf(stderr, "kernel_launch: launch failed: %s\n", hipGetErrorName(le));
}
```

```cpp
#include <hip/hip_runtime.h>
#include <cstdio>
#include <cstdint>
namespace pg8 {
#define PG8_LAS __attribute__((address_space(3)))
typedef unsigned short bf16_t;
typedef short bf16x8 __attribute__((ext_vector_type(8)));
typedef float f32x4 __attribute__((ext_vector_type(4)));
typedef unsigned u32x4 __attribute__((ext_vector_type(4)));
constexpr int BM = 256, BK = 64, HALF = 128, HTB = HALF * BK * 2  , STAGE_BYTES = 8 * HTB, NXCD = 8, WGM = 8;

__host__ __device__ __forceinline__ int lds_byte(int r, int c) { const int st = (r >> 4) * 2 + (c >> 5), rr = r & 15, cc = c & 31, ob = rr * 64 + cc * 2; return st * 1024 + (ob ^ (((ob >> 9) & 1) << 5)); }
__host__ __device__ __forceinline__ void stage_rc(int b, int& R, int& C) { const int st = b / 1024, sb = b % 1024, swz = sb ^ (((sb >> 9) & 1) << 5); R = (st >> 1) * 16 + swz / 64; C = (st & 1) * 32 + (swz % 64) / 2; }
__host__ __device__ __forceinline__ int perm32(int rho) { const int n = rho >> 4, i = rho & 15; return 8 * (i >> 2) + 4 * n + (i & 3); }

struct Unit { int pm, pn; };
struct Gemm { const bf16_t* A; const bf16_t* Bt; int M, N, K, lda; };

struct StaticOrder {
    int nM, nN, nwg, G, c;
    __host__ __device__ void init(int M, int N, int G_, int c_) { nM = M / BM; nN = N / BM; nwg = nM * nN; G = G_; c = c_; }
    __host__ __device__ bool next(int i, Unit& u) const {
        const long L = (long)i * G + c; if (L >= nwg) return false;
        int wgid = (int)L; { const int q = nwg / NXCD, r = nwg % NXCD, xcd = wgid % NXCD, off = wgid / NXCD; wgid = (xcd < r ? xcd * (q + 1) : r * (q + 1) + (xcd - r) * q) + off; }
        const int nig = WGM * nN, gid = wgid / nig, fm = gid * WGM, gsz = (nM - fm) < WGM ? (nM - fm) : WGM;
        u.pm = fm + ((wgid % nig) % gsz); u.pn = (wgid % nig) / gsz; return true;
    }
    __device__ __forceinline__ void a_ready(const Unit&) const {}
    __device__ __forceinline__ void done(const Unit&) const {}
};

__device__ __forceinline__ unsigned cvt_pk_bf16(float lo, float hi) { unsigned r; asm volatile("v_cvt_pk_bf16_f32 %0, %1, %2" : "=v"(r) : "v"(lo), "v"(hi)); return r; }
typedef float f32x2 __attribute__((ext_vector_type(2)));
struct EpiF32 {
    static constexpr bool PERM = false, AFTER_DRAIN = false;
    float* C; int ldc;
    __device__ __forceinline__ void operator()(const f32x4 (&acc)[2][2][4][2], const Unit& u, int wr, int wc, int fr, int fq) const {
        const int row0 = u.pm * BM + wr * 64 + fr, col0 = u.pn * BM + wc * 32 + 4 * fq;
#pragma unroll
        for (int ai = 0; ai < 2; ++ai)
#pragma unroll
            for (int m = 0; m < 4; ++m) { float* rowp = C + (size_t)(row0 + ai * HALF + m * 16) * ldc + col0;
#pragma unroll
                for (int bj = 0; bj < 2; ++bj)
#pragma unroll
                    for (int n = 0; n < 2; ++n) *(f32x4*)(rowp + bj * HALF + n * 16) = acc[ai][bj][m][n]; }
    }
};
struct EpiBf16P {
    static constexpr bool PERM = true, AFTER_DRAIN = false;
    bf16_t* O; int ldc;
    __device__ __forceinline__ void operator()(const f32x4 (&acc)[2][2][4][2], const Unit& u, int wr, int wc, int fr, int fq) const {
        const int row0 = u.pm * BM + wr * 64 + fr, col0 = u.pn * BM + wc * 32 + 8 * fq;
#pragma unroll
        for (int ai = 0; ai < 2; ++ai)
#pragma unroll
            for (int m = 0; m < 4; ++m) { bf16_t* rowp = O + (size_t)(row0 + ai * HALF + m * 16) * ldc + col0;
#pragma unroll
                for (int bj = 0; bj < 2; ++bj) { const f32x4 v0 = acc[ai][bj][m][0], v1 = acc[ai][bj][m][1];
                    u32x4 w; w.x = cvt_pk_bf16(v0[0], v0[1]); w.y = cvt_pk_bf16(v0[2], v0[3]); w.z = cvt_pk_bf16(v1[0], v1[1]); w.w = cvt_pk_bf16(v1[2], v1[3]);
                    *(u32x4*)(rowp + bj * HALF) = w; } }
    }
};
__device__ __forceinline__ const float* tabf(const PG8_LAS unsigned char* tab, int k) {
    const volatile PG8_LAS unsigned* t = (const volatile PG8_LAS unsigned*)tab + 2 * k;
    const unsigned lo = __builtin_amdgcn_readfirstlane(t[0]), hi = __builtin_amdgcn_readfirstlane(t[1]);
    return (const float*)(((unsigned long long)hi << 32) | lo);
}
__device__ __forceinline__ float dpp_shr1(float old, float src) { return __builtin_bit_cast(float, __builtin_amdgcn_update_dpp(__builtin_bit_cast(int, old), __builtin_bit_cast(int, src), 0x111, 0xf, 0xf, false)); }
__device__ __forceinline__ float dpp_shr2(float old, float src) { return __builtin_bit_cast(float, __builtin_amdgcn_update_dpp(__builtin_bit_cast(int, old), __builtin_bit_cast(int, src), 0x112, 0xf, 0xf, false)); }
__device__ __forceinline__ float dpp_ror1(float src) { return __builtin_bit_cast(float, __builtin_amdgcn_update_dpp(0, __builtin_bit_cast(int, src), 0x121, 0xf, 0xf, false)); }
__device__ __forceinline__ float dpp_ror2(float src) { return __builtin_bit_cast(float, __builtin_amdgcn_update_dpp(0, __builtin_bit_cast(int, src), 0x122, 0xf, 0xf, false)); }
__device__ __forceinline__ float gelu_tanh(float x) {
    const float t = x * (1.0f + 0.044715f * x * x) * (-2.0f * 0.7978845608028654f * 1.4426950408889634f);
    return x * __builtin_amdgcn_rcpf(1.0f + __builtin_amdgcn_exp2f(t));
}
typedef unsigned u32x2 __attribute__((ext_vector_type(2)));
struct EpiConv {
    static constexpr bool PERM = true, AFTER_DRAIN = false;
    bf16_t* act; const PG8_LAS unsigned char* tab; int l; size_t halo_off; PG8_LAS float* scr;
    __device__ __forceinline__ void operator()(const f32x4 (&acc)[2][2][4][2], const Unit& u, int wr, int wc, int fr, int fq) const {
        const float* cw = tabf(tab, 29) + (size_t)l * 3 * 5632; const float* cb = tabf(tab, 30) + l * 5632;
        float* uhalo = (float*)((unsigned char*)tabf(tab, 32) + halo_off); float* ufix = uhalo + (size_t)128 * 2 * 5632;
        const int jg = u.pn * 128 + wc * 32 + 8 * fq;
        if (fr >= 14) {
#pragma unroll
            for (int ai = 0; ai < 2; ++ai) { const int grp = 2 * ai + wr; PG8_LAS float* base = scr + ((wc * 4 + grp) * 2 + (fr - 14)) * 64 + fq * 16;
#pragma unroll
                for (int bj = 0; bj < 2; ++bj)
#pragma unroll
                    for (int n = 0; n < 2; ++n) *(PG8_LAS f32x4*)(base + bj * 8 + n * 4) = acc[ai][bj][3][n]; }
            if (wr == 1) { float* hp = uhalo + ((size_t)u.pm * 2 + (fr - 14)) * 5632 + jg;
#pragma unroll
                for (int bj = 0; bj < 2; ++bj)
#pragma unroll
                    for (int n = 0; n < 2; ++n) *(f32x4*)(hp + bj * 2816 + 4 * n) = acc[1][bj][3][n]; }
        }
        if (wr == 0 && fr < 2) { float* fp = ufix + ((size_t)u.pm * 2 + fr) * 5632 + jg;
#pragma unroll
            for (int bj = 0; bj < 2; ++bj)
#pragma unroll
                for (int n = 0; n < 2; ++n) *(f32x4*)(fp + bj * 2816 + 4 * n) = acc[0][bj][0][n]; }
        asm volatile("s_waitcnt lgkmcnt(0)" ::: "memory"); __builtin_amdgcn_s_barrier(); asm volatile("" ::: "memory");
#pragma unroll
        for (int n = 0; n < 2; ++n) {
            f32x4 wg[3], wv[3];
#pragma unroll
            for (int k = 0; k < 3; ++k) { wg[k] = *(const f32x4*)(cw + k * 5632 + jg + 4 * n); wv[k] = *(const f32x4*)(cw + k * 5632 + 2816 + jg + 4 * n); }
            const f32x4 bg = *(const f32x4*)(cb + jg + 4 * n), bv = *(const f32x4*)(cb + 2816 + jg + 4 * n);
#pragma unroll
            for (int ai = 0; ai < 2; ++ai) {
                const int grp = 2 * ai + wr;
                f32x4 h0[2], h1[2];
                { const PG8_LAS float* base = scr + ((wc * 4 + (grp > 0 ? grp - 1 : 0)) * 2) * 64 + fq * 16 + n * 4;
#pragma unroll
                  for (int bj = 0; bj < 2; ++bj) { h0[bj] = *(const PG8_LAS f32x4*)(base + bj * 8); h1[bj] = *(const PG8_LAS f32x4*)(base + 64 + bj * 8); } }
#pragma unroll
                for (int m = 0; m < 4; ++m) {
                    f32x4 p1[2], p2[2], o;
#pragma unroll
                    for (int bj = 0; bj < 2; ++bj)
#pragma unroll
                        for (int j = 0; j < 4; ++j) { const float cur = acc[ai][bj][m][n][j]; float x1, x2;
                            if (m > 0) { const float pv = acc[ai][bj][m > 0 ? m - 1 : 0][n][j]; x1 = dpp_ror1(pv); x2 = dpp_ror2(pv); }
                            else { x1 = h1[bj][j]; x2 = (fr == 0) ? h0[bj][j] : h1[bj][j]; }
                            p1[bj][j] = dpp_shr1(x1, cur); p2[bj][j] = dpp_shr2(x2, cur); }
#pragma unroll
                    for (int j = 0; j < 4; ++j) {
                        const float g = bg[j] + wg[0][j] * p2[0][j] + wg[1][j] * p1[0][j] + wg[2][j] * acc[ai][0][m][n][j];
                        const float v = bv[j] + wv[0][j] * p2[1][j] + wv[1][j] * p1[1][j] + wv[2][j] * acc[ai][1][m][n][j];
                        o[j] = gelu_tanh(g) * v; }
                    const int rit = ai * HALF + wr * 64 + m * 16 + fr;
                    if (!(grp == 0 && m == 0 && fr < 2)) {
                        u32x2 w; w.x = cvt_pk_bf16(o[0], o[1]); w.y = cvt_pk_bf16(o[2], o[3]);
                        *(u32x2*)(act + (size_t)(u.pm * BM + rit) * 2816 + jg + 4 * n) = w; }
                }
            }
        }
    }
};

__device__ __forceinline__ float dpp_shr3(float old, float src) { return __builtin_bit_cast(float, __builtin_amdgcn_update_dpp(__builtin_bit_cast(int, old), __builtin_bit_cast(int, src), 0x113, 0xf, 0xf, false)); }
__device__ __forceinline__ float dpp_ror3(float src) { return __builtin_bit_cast(float, __builtin_amdgcn_update_dpp(0, __builtin_bit_cast(int, src), 0x123, 0xf, 0xf, false)); }
__device__ __forceinline__ float silu_f(float x) { return x * __builtin_amdgcn_rcpf(1.0f + __builtin_amdgcn_exp2f(x * -1.4426950408889634f)); }
struct EpiIn {
    static constexpr bool PERM = true, AFTER_DRAIN = false;
    bf16_t* O; const PG8_LAS unsigned char* tab; int l; size_t halo_off; PG8_LAS float* scr;
    __device__ __forceinline__ void operator()(const f32x4 (&acc)[2][2][4][2], const Unit& u, int wr, int wc, int fr, int fq) const {
        const int row0 = u.pm * BM + wr * 64 + fr, cl = wc * 32 + 8 * fq;
        if (u.pn >= 8) {
            const int col0 = u.pn * BM + cl;
#pragma unroll
            for (int ai = 0; ai < 2; ++ai)
#pragma unroll
                for (int m = 0; m < 4; ++m) { bf16_t* rowp = O + (size_t)(row0 + ai * HALF + m * 16) * 4096 + col0;
#pragma unroll
                    for (int bj = 0; bj < 2; ++bj) { const f32x4 v0 = acc[ai][bj][m][0], v1 = acc[ai][bj][m][1];
                        u32x4 w; w.x = cvt_pk_bf16(v0[0], v0[1]); w.y = cvt_pk_bf16(v0[2], v0[3]); w.z = cvt_pk_bf16(v1[0], v1[1]); w.w = cvt_pk_bf16(v1[2], v1[3]);
                        *(u32x4*)(rowp + bj * HALF) = w; } }
            return;
        }
        const bool act = (u.pn < 2) || (u.pn >= 4);
        const float* cw; const float* cb; int cst, ch0;
        if (u.pn < 2) { cw = tabf(tab, 6) + (size_t)l * 2048; cb = tabf(tab, 7) + l * 512; cst = 512; ch0 = u.pn * 256; } else if (u.pn < 4) { cw = tabf(tab, 14) + (size_t)l * 2048; cb = tabf(tab, 15) + l * 512; cst = 512; ch0 = (u.pn - 2) * 256; }
        else { cw = tabf(tab, 21) + (size_t)l * 4096; cb = tabf(tab, 22) + l * 1024; cst = 1024; ch0 = (u.pn - 4) * 256; }
        float* uhalo = (float*)((unsigned char*)tabf(tab, 32) + halo_off); float* ufix = uhalo + (size_t)128 * 3 * 2048;
        const int ccol = u.pn * BM + cl;
        if (fr >= 13) {
#pragma unroll
            for (int ai = 0; ai < 2; ++ai) { const int grp = 2 * ai + wr; PG8_LAS float* base = scr + ((wc * 4 + grp) * 3 + (fr - 13)) * 64 + fq * 16;
#pragma unroll
                for (int bj = 0; bj < 2; ++bj)
#pragma unroll
                    for (int n = 0; n < 2; ++n) *(PG8_LAS f32x4*)(base + bj * 8 + n * 4) = acc[ai][bj][3][n]; }
            if (wr == 1) { float* hp = uhalo + ((size_t)u.pm * 3 + (fr - 13)) * 2048 + ccol;
#pragma unroll
                for (int bj = 0; bj < 2; ++bj)
#pragma unroll
                    for (int n = 0; n < 2; ++n) *(f32x4*)(hp + bj * HALF + 4 * n) = acc[1][bj][3][n]; }
        }
        if (wr == 0 && fr < 3) { float* fp = ufix + ((size_t)u.pm * 3 + fr) * 2048 + ccol;
#pragma unroll
            for (int bj = 0; bj < 2; ++bj)
#pragma unroll
                for (int n = 0; n < 2; ++n) *(f32x4*)(fp + bj * HALF + 4 * n) = acc[0][bj][0][n]; }
        asm volatile("s_waitcnt lgkmcnt(0)" ::: "memory"); __builtin_amdgcn_s_barrier(); asm volatile("" ::: "memory");
#pragma unroll
        for (int bj = 0; bj < 2; ++bj) {
#pragma unroll
            for (int n = 0; n < 2; ++n) {
                const int ch = ch0 + bj * HALF + cl + 4 * n;
                f32x4 w[4];
#pragma unroll
                for (int k = 0; k < 4; ++k) w[k] = *(const f32x4*)(cw + k * cst + ch);
                const f32x4 bb = *(const f32x4*)(cb + ch);
#pragma unroll
                for (int ai = 0; ai < 2; ++ai) {
                    const int grp = 2 * ai + wr;
                    const PG8_LAS float* base = scr + ((wc * 4 + (grp > 0 ? grp - 1 : 0)) * 3) * 64 + fq * 16 + bj * 8 + n * 4;
                    const f32x4 h0 = *(const PG8_LAS f32x4*)(base), h1 = *(const PG8_LAS f32x4*)(base + 64), h2 = *(const PG8_LAS f32x4*)(base + 128);
#pragma unroll
                    for (int m = 0; m < 4; ++m) {
                        f32x4 o;
#pragma unroll
                        for (int j = 0; j < 4; ++j) { const float cur = acc[ai][bj][m][n][j]; float x1, x2, x3;
                            if (m > 0) { const float pv = acc[ai][bj][m > 0 ? m - 1 : 0][n][j]; x1 = dpp_ror1(pv); x2 = dpp_ror2(pv); x3 = dpp_ror3(pv); }
                            else { x1 = h2[j]; x2 = (fr == 0) ? h1[j] : h2[j]; x3 = (fr == 0) ? h0[j] : (fr == 1 ? h1[j] : h2[j]); }
                            const float p1 = dpp_shr1(x1, cur), p2 = dpp_shr2(x2, cur), p3 = dpp_shr3(x3, cur);
                            const float v = bb[j] + w[0][j] * p3 + w[1][j] * p2 + w[2][j] * p1 + w[3][j] * cur;
                            o[j] = act ? silu_f(v) : v; }
                        const int rit = ai * HALF + wr * 64 + m * 16 + fr;
                        if (!(grp == 0 && m == 0 && fr < 3)) { u32x2 wv; wv.x = cvt_pk_bf16(o[0], o[1]); wv.y = cvt_pk_bf16(o[2], o[3]);
                            *(u32x2*)(O + (size_t)(u.pm * BM + rit) * 4096 + ccol + bj * HALF + 4 * n) = wv; }
                    }
                }
            }
        }
    }
};
template <class Epi, class Sched, bool ALIGN_EPI = false, bool SP2 = false>
__device__ __forceinline__ void gemm_phase(PG8_LAS unsigned char* lds, const Gemm g, const Sched& S, const Epi& E) {
    int tid_ = threadIdx.x; asm volatile("" : "+v"(tid_));
    const int tid = tid_, wid = __builtin_amdgcn_readfirstlane(tid >> 6), lane = tid & 63, wr = wid >> 2, wc = wid & 3, fr = lane & 15, fq = lane >> 4;
    const int K = g.K, nt = K / BK;
    unsigned voffA[2], voffB[2];
#pragma unroll
    for (int i = 0; i < 2; ++i) { int R, C; stage_rc(tid * 16 + i * 8192, R, C); const int Rb = Epi::PERM ? ((R & ~31) + perm32(R & 31)) : R;
        voffA[i] = (unsigned)(R * g.lda + C) * 2u; voffB[i] = (unsigned)(Rb * K + C) * 2u; }
    const size_t kstep = (size_t)(BK * 2);
    const size_t hstep = (size_t)HALF * K * 2;
    const size_t tstep = 2 * hstep; const size_t hstepA = (size_t)HALF * g.lda * 2, tstepA = 2 * hstepA;
    const unsigned ldsw = (unsigned)wid * 1024u;
    const int aoff = lds_byte(wr * 64 + fr, fq * 8), boff = lds_byte(wc * 32 + fr, fq * 8);
#define PG8_SA(b, h) (((b) * 2 + (h)) * HTB)
#define PG8_SB(b, h) ((4 + (b) * 2 + (h)) * HTB)
#define PG8_STAGE(bufoff, gbase, voff) do { _Pragma("unroll") for (int _i = 0; _i < 2; ++_i) \
        __builtin_amdgcn_global_load_lds((const unsigned*)((const char*)(gbase) + (voff)[_i]), (PG8_LAS unsigned*)(lds + (bufoff) + ldsw + _i * 8192), 16, 0, 0); } while (0)
#define PG8_LDA(dst, b, h) do { _Pragma("unroll") for (int m = 0; m < 4; ++m) _Pragma("unroll") for (int k = 0; k < 2; ++k) dst[m][k] = *(const PG8_LAS bf16x8*)(lds + PG8_SA(b, h) + aoff + m * 2048 + k * 1024); } while (0)
#define PG8_LDB(dst, b, h) do { _Pragma("unroll") for (int n = 0; n < 2; ++n) _Pragma("unroll") for (int k = 0; k < 2; ++k) dst[n][k] = *(const PG8_LAS bf16x8*)(lds + PG8_SB(b, h) + boff + n * 2048 + k * 1024); } while (0)
#define PG8_MMA(ai, bj, At, Bt) do { __builtin_amdgcn_s_setprio(1); _Pragma("unroll") for (int m = 0; m < 4; ++m) _Pragma("unroll") for (int n = 0; n < 2; ++n) _Pragma("unroll") for (int k = 0; k < 2; ++k) \
        acc[ai][bj][m][n] = __builtin_amdgcn_mfma_f32_16x16x32_bf16(Bt[n][k], At[m][k], acc[ai][bj][m][n], 0, 0, 0); __builtin_amdgcn_s_setprio(0); } while (0)
#define PG8_WAIT_V(n) asm volatile("s_waitcnt vmcnt(" #n ")" ::: "memory")
#define PG8_WAIT_L(n) asm volatile("s_waitcnt lgkmcnt(" #n ")" ::: "memory")
#define PG8_BAR __builtin_amdgcn_s_barrier()
#define PG8_SCHED __builtin_amdgcn_sched_barrier(0)
    Unit cur, nxt; int ui = 0;
    if (!S.next(0, cur)) return;
    f32x4 acc[2][2][4][2];
#pragma unroll
    for (int a = 0; a < 2; ++a)
#pragma unroll
        for (int b = 0; b < 2; ++b)
#pragma unroll
            for (int m = 0; m < 4; ++m)
#pragma unroll
                for (int n = 0; n < 2; ++n) acc[a][b][m][n] = (f32x4){0.f, 0.f, 0.f, 0.f};
    bf16x8 At[4][2], B0[2][2], B1[2][2];
    const char* cA = (const char*)g.A + (size_t)cur.pm * tstepA; const char* cB = (const char*)g.Bt + (size_t)cur.pn * tstep;
    S.a_ready(cur);
    if constexpr (SP2) {
        PG8_STAGE(PG8_SB(0, 0), cB, voffB); PG8_STAGE(PG8_SB(0, 1), cB + hstep, voffB); PG8_STAGE(PG8_SA(0, 0), cA, voffA); PG8_STAGE(PG8_SA(0, 1), cA + hstepA, voffA);
        if (wr == 1) PG8_BAR;
        PG8_WAIT_V(2); PG8_BAR;
        PG8_STAGE(PG8_SB(1, 0), cB + kstep, voffB); PG8_STAGE(PG8_SA(1, 0), cA + kstep, voffA); PG8_STAGE(PG8_SB(1, 1), cB + hstep + kstep, voffB);
        PG8_WAIT_V(6); PG8_BAR;
    } else {
        PG8_STAGE(PG8_SB(0, 0), cB, voffB); PG8_STAGE(PG8_SA(0, 0), cA, voffA); PG8_STAGE(PG8_SB(0, 1), cB + hstep, voffB); PG8_STAGE(PG8_SA(0, 1), cA + hstepA, voffA);
        if (wr == 1) PG8_BAR;
        PG8_WAIT_V(4); PG8_BAR;
        PG8_STAGE(PG8_SB(1, 0), cB + kstep, voffB); PG8_STAGE(PG8_SA(1, 0), cA + kstep, voffA); PG8_STAGE(PG8_SB(1, 1), cB + hstep + kstep, voffB);
        PG8_WAIT_V(6); PG8_BAR;
    }
    for (;;) {
        const bool has_next = S.next(ui + 1, nxt);
        const char* nA = has_next ? (const char*)g.A + (size_t)nxt.pm * tstepA : cA; const char* nB = has_next ? (const char*)g.Bt + (size_t)nxt.pn * tstep : cB;
        for (int t = 0; t < nt; t += 2) {
            const bool last = (t == nt - 2);
            const char* a1 = cA + (size_t)(t + 1) * kstep;
            const char* a2 = last ? nA : cA + (size_t)(t + 2) * kstep; const char* b2 = last ? nB : cB + (size_t)(t + 2) * kstep;
            const char* a3 = a2 + kstep; const char* b3 = b2 + kstep;
            if (last && has_next) S.a_ready(nxt);
            if constexpr (SP2) {
            PG8_LDB(B0, 0, 0); PG8_LDB(B1, 0, 1); PG8_SCHED; PG8_LDA(At, 0, 0); PG8_STAGE(PG8_SA(1, 1), a1 + hstepA, voffA);
            PG8_WAIT_V(8); PG8_WAIT_L(0); PG8_BAR; PG8_MMA(0, 0, At, B0); PG8_MMA(0, 1, At, B1); PG8_BAR; PG8_SCHED;
            PG8_LDA(At, 0, 1); PG8_STAGE(PG8_SB(0, 0), b2, voffB); PG8_STAGE(PG8_SB(0, 1), b2 + hstep, voffB); PG8_STAGE(PG8_SA(0, 0), a2, voffA);
            PG8_WAIT_V(8); PG8_WAIT_L(0); PG8_BAR; PG8_MMA(1, 0, At, B0); PG8_MMA(1, 1, At, B1); PG8_BAR; PG8_SCHED;
            PG8_LDB(B0, 1, 0); PG8_LDB(B1, 1, 1); PG8_SCHED; PG8_LDA(At, 1, 0); PG8_STAGE(PG8_SA(0, 1), a2 + hstepA, voffA);
            PG8_WAIT_V(8); PG8_WAIT_L(0); PG8_BAR; PG8_MMA(0, 0, At, B0); PG8_MMA(0, 1, At, B1); PG8_BAR; PG8_SCHED;
            PG8_LDA(At, 1, 1); PG8_STAGE(PG8_SB(1, 0), b3, voffB); PG8_STAGE(PG8_SB(1, 1), b3 + hstep, voffB); PG8_STAGE(PG8_SA(1, 0), a3, voffA);
            PG8_WAIT_V(8); PG8_WAIT_L(0); PG8_BAR; PG8_MMA(1, 0, At, B0); PG8_MMA(1, 1, At, B1); PG8_BAR; PG8_SCHED;
            } else {
            PG8_LDB(B0, 0, 0); PG8_SCHED; PG8_LDA(At, 0, 0); PG8_STAGE(PG8_SA(1, 1), a1 + hstepA, voffA);
            PG8_WAIT_L(8); PG8_BAR; PG8_WAIT_L(0); PG8_MMA(0, 0, At, B0); PG8_BAR; PG8_SCHED;
            PG8_LDB(B1, 0, 1); PG8_STAGE(PG8_SB(0, 0), b2, voffB);
            PG8_BAR; PG8_WAIT_L(0); PG8_MMA(0, 1, At, B1); PG8_BAR;
            PG8_LDA(At, 0, 1); PG8_STAGE(PG8_SA(0, 0), a2, voffA);
            PG8_BAR; PG8_WAIT_L(0); PG8_MMA(1, 0, At, B0); PG8_BAR; PG8_SCHED;
            PG8_STAGE(PG8_SB(0, 1), b2 + hstep, voffB);
            PG8_WAIT_V(6); PG8_BAR; PG8_MMA(1, 1, At, B1); PG8_BAR;
            PG8_LDB(B0, 1, 0); PG8_SCHED; PG8_LDA(At, 1, 0); PG8_STAGE(PG8_SA(0, 1), a2 + hstepA, voffA);
            PG8_WAIT_L(8); PG8_BAR; PG8_WAIT_L(0); PG8_MMA(0, 0, At, B0); PG8_BAR; PG8_SCHED;
            PG8_LDB(B1, 1, 1); PG8_STAGE(PG8_SB(1, 0), b3, voffB);
            PG8_BAR; PG8_WAIT_L(0); PG8_MMA(0, 1, At, B1); PG8_BAR;
            PG8_LDA(At, 1, 1); PG8_STAGE(PG8_SA(1, 0), a3, voffA);
            PG8_BAR; PG8_WAIT_L(0); PG8_MMA(1, 0, At, B0); PG8_BAR; PG8_SCHED;
            PG8_STAGE(PG8_SB(1, 1), b3 + hstep, voffB);
            PG8_WAIT_V(6); PG8_BAR; PG8_MMA(1, 1, At, B1); PG8_BAR;
            }
        }
        if constexpr (ALIGN_EPI) { if (wr == 0) PG8_BAR; }
        if constexpr (!Epi::AFTER_DRAIN) { E(acc, cur, wr, wc, fr, fq); S.done(cur); }
        if (!has_next) break;
#pragma unroll
        for (int a = 0; a < 2; ++a)
#pragma unroll
            for (int b = 0; b < 2; ++b)
#pragma unroll
                for (int m = 0; m < 4; ++m)
#pragma unroll
                    for (int n = 0; n < 2; ++n) acc[a][b][m][n] = (f32x4){0.f, 0.f, 0.f, 0.f};
        cur = nxt; cA = nA; cB = nB; ++ui;
        if constexpr (ALIGN_EPI) { if (wr == 1) PG8_BAR; }
    }
    PG8_WAIT_V(0);
    if constexpr (!ALIGN_EPI) { if (wr == 0) PG8_BAR; }
    PG8_BAR;
    if constexpr (Epi::AFTER_DRAIN) { E.fused(acc, cur, wr, wc, fr, fq, lds, wid, lane); S.done(cur); }
#undef PG8_SA
#undef PG8_SB
#undef PG8_STAGE
#undef PG8_LDA
#undef PG8_LDB
#undef PG8_MMA
#undef PG8_WAIT_V
#undef PG8_WAIT_L
#undef PG8_BAR
#undef PG8_SCHED
}
}


#ifndef PG8_SP2
#define PG8_SP2 true
#endif
#ifndef PG8_ALIGN
#define PG8_ALIGN true
#endif
constexpr int NWAVES = 8, NTHR = 512;
#ifndef MK_PER_PHASE
#define MK_PER_PHASE 0
#endif
constexpr int BATCH = 8, SEQ = 4096, TOK = BATCH * SEQ, DM = 1024, NP = 4096, DFF = 2816, NUP = 5632, KMIX = 1536, NCHK = 64, DEPTH = 2;
constexpr int PC_XC = 0, PC_XR = 512, PC_XBC = 1024, PC_OM = 2048, PC_YR = 2560, PC_ZS = 3072, PC_V = 3584;
constexpr float EPS = 1e-6f;
constexpr int PH_PER_LAYER = 11, NPHASES = 1 + PH_PER_LAYER * DEPTH;
constexpr size_t W_IN = 0, W_OUT = W_IN + (size_t)4112 * 1024, W_UP = W_OUT + (size_t)1024 * 1536, W_DN = W_UP + (size_t)5632 * 1024, W_Q = W_DN + (size_t)1024 * 2816,
                 W_K = W_Q + 65536, W_V = W_K + 65536, W_A = W_V + 65536, W_X = W_A + 32768, W_LAYER = W_X + 32768;
constexpr size_t MiB = 1u << 20;
constexpr size_t WS_CTL = 0, CTL_ZERO_BYTES = 1 * MiB;
constexpr size_t WS_W = 1 * MiB, WS_XN = 58 * MiB, WS_P = 122 * MiB, WS_PS = 378 * MiB, WS_MC = 380 * MiB, WS_SS = 444 * MiB, WS_Y = WS_MC, WS_END = 508 * MiB;
constexpr size_t WS_MN = WS_XN, WS_MS = WS_XN + 1 * MiB, WS_RG = WS_XN + 2 * MiB;
constexpr size_t WS_HALO = WS_MC;
constexpr size_t WS_HALO_IN = WS_SS;
static_assert(WS_W + 2 * W_LAYER * 2 <= WS_XN, "weights fit");
constexpr int CW_TMO = 0, CW_BAR = 4096;
constexpr int RING_OFF = 0, RING_BYTES = 131072, LDSCTL_OFF = RING_BYTES, MISC_OFF = LDSCTL_OFF + 320, PTR_OFF = LDSCTL_OFF + 512, EPI_OFF = LDSCTL_OFF + 1024, LDS_BYTES = 147456;
static_assert(EPI_OFF + 12288 <= LDS_BYTES, "epilogue scratch");

#define GAS __attribute__((address_space(1)))
#define LAS __attribute__((address_space(3)))
typedef unsigned short bf16;
typedef unsigned v4u __attribute__((ext_vector_type(4)));
typedef unsigned v2u __attribute__((ext_vector_type(2)));
typedef float f32x4 __attribute__((ext_vector_type(4)));
typedef short bf16x8 __attribute__((ext_vector_type(8)));
typedef GAS unsigned gu32;
#define RLX_AGENT __ATOMIC_RELAXED, __HIP_MEMORY_SCOPE_AGENT
#define LDS_WAIT() asm volatile("s_waitcnt lgkmcnt(0)" ::: "memory")
#define VM_WAIT() asm volatile("s_waitcnt vmcnt(0)" ::: "memory")
__device__ __forceinline__ unsigned f2bf(float f) { unsigned u = __builtin_bit_cast(unsigned, f); return (u + 0x7fffu + ((u >> 16) & 1u)) >> 16; }
__device__ __forceinline__ unsigned pk2(float lo, float hi) { return f2bf(lo) | (f2bf(hi) << 16); }
__device__ __forceinline__ float bf2f(unsigned b) { return __builtin_bit_cast(float, b << 16); }
__device__ __forceinline__ float lo16(unsigned w) { return __builtin_bit_cast(float, w << 16); }
__device__ __forceinline__ float hi16(unsigned w) { return __builtin_bit_cast(float, w & 0xffff0000u); }
__device__ __forceinline__ float sigmoidf_(float x) { return __builtin_amdgcn_rcpf(1.0f + __expf(-x)); }
__device__ __forceinline__ float siluf_(float x) { return x * sigmoidf_(x); }
__device__ __forceinline__ float softplusf_(float x) { return fmaxf(x, 0.f) + log1pf(__expf(-fabsf(x))); }
#define XB_TMO      128
#define XB_XCNT(j)  (256  + 64 * (j))
#define XB_XSUB(j)  (1280 + 64 * (j))
#define XB_XGEN(j)  (2304 + 64 * (j))
#define XB_TOP      3328
#define XB_TOPGEN   3392
#define XCD_BAR_WORDS 3456
#define XB_SPIN_CAP (1u << 18)

__device__ __forceinline__ unsigned xb_ld(unsigned* p)              { return __hip_atomic_load(p, __ATOMIC_RELAXED, __HIP_MEMORY_SCOPE_AGENT); }
__device__ __forceinline__ unsigned xb_add(unsigned* p, unsigned v) { return __hip_atomic_fetch_add(p, v, __ATOMIC_RELAXED, __HIP_MEMORY_SCOPE_AGENT); }
__device__ __forceinline__ unsigned xb_xcc_id() { return (unsigned)__builtin_amdgcn_s_getreg((3 << 11) | 20) & 0xFu; }
#define XB_SPIN(cond, bar) do { unsigned _sp = 0; while (cond) { __builtin_amdgcn_s_sleep(1); \
    if ((++_sp & 255u) == 0u) { if (xb_ld(&(bar)[XB_TMO])) break; if (_sp > XB_SPIN_CAP) { atomicAdd(&(bar)[XB_TMO], 1u); break; } } } } while (0)

struct XcdBarrier {
    unsigned* bar; unsigned x;
    volatile LAS unsigned* st;
};

__device__ __forceinline__ XcdBarrier xcd_barrier_post(unsigned* bar, volatile LAS unsigned* st) {
    XcdBarrier b; b.bar = bar; b.x = xb_xcc_id(); b.st = st;
    if (threadIdx.x == 0) (void)xb_add(&bar[XB_XCNT(b.x)], 1u);
    return b;
}
__device__ __forceinline__ void xcd_barrier_complete(unsigned* bar, unsigned x, unsigned& nloc, unsigned& nx) {
    const unsigned G = gridDim.x * gridDim.y * gridDim.z;
    unsigned sum, cnt, mine, sp = 0u;
    for (;;) {
        sum = 0u; cnt = 0u; mine = 0u;
#pragma unroll
        for (unsigned j = 0; j < 16; ++j) { const unsigned c = xb_ld(&bar[XB_XCNT(j)]); sum += c; cnt += (c > 0u) ? 1u : 0u; mine = (j == x) ? c : mine; }
        if (sum == G) break;
        __builtin_amdgcn_s_sleep(1);
        if ((++sp & 255u) == 0u) { if (xb_ld(&bar[XB_TMO])) break; if (sp > XB_SPIN_CAP) { atomicAdd(&bar[XB_TMO], 1u); break; } }
    }
    nloc = mine > 0u ? mine : 1u; nx = cnt > 0u ? cnt : 1u;
}

__device__ __forceinline__ void xcd_barrier(const XcdBarrier& b) {
    asm volatile("s_waitcnt vmcnt(0)" ::: "memory");
    __syncthreads();
    if (threadIdx.x == 0) {
        unsigned* bar = b.bar;
        __builtin_amdgcn_s_waitcnt(0);
        unsigned nloc = b.st[0], nx = b.st[1];
        if (nloc == 0u) { xcd_barrier_complete(bar, b.x, nloc, nx); b.st[0] = nloc; b.st[1] = nx; }
        const unsigned old = xb_add(&bar[XB_XSUB(b.x)], 1u);
        const unsigned gen = old / nloc;
        if (old + 1u == (gen + 1u) * nloc) {
            __builtin_amdgcn_fence(__ATOMIC_RELEASE, "agent");
            asm volatile("s_waitcnt vmcnt(0)" ::: "memory");
            const unsigned og = xb_add(&bar[XB_TOP], 1u);
            const unsigned tg = og / nx;
            if (og + 1u == (tg + 1u) * nx) xb_add(&bar[XB_TOPGEN], 1u);
            else XB_SPIN(xb_ld(&bar[XB_TOPGEN]) == tg, bar);
            __builtin_amdgcn_fence(__ATOMIC_ACQUIRE, "agent");
            xb_add(&bar[XB_XGEN(b.x)], 1u);
            asm volatile("s_waitcnt vmcnt(0)" ::: "memory");
        } else {
            XB_SPIN(xb_ld(&bar[XB_XGEN(b.x)]) == gen, bar);
            __builtin_amdgcn_fence(__ATOMIC_ACQUIRE, "agent");
            asm volatile("s_waitcnt vmcnt(0)" ::: "memory");
        }
    }
    __syncthreads();
}

struct Args { const float* in[32]; float* out; unsigned char* ws; int ph_lo, ph_hi; };
struct Frame {
    LAS unsigned char* lds; volatile LAS unsigned* MISC; gu32* ctl;
    int tid, lane, wave, vcu, G;
    unsigned char* ws;
};
__device__ __forceinline__ const float* inp(const Frame& F, int k) {
    const volatile LAS unsigned* t = (const volatile LAS unsigned*)(F.lds + PTR_OFF) + 2 * k;
    const unsigned lo = __builtin_amdgcn_readfirstlane(t[0]), hi = __builtin_amdgcn_readfirstlane(t[1]);
    return (const float*)(((unsigned long long)hi << 32) | lo);
}
__device__ __forceinline__ const bf16* wlayer(const Frame& F, int l) { return (const bf16*)(F.ws + WS_W) + (size_t)l * W_LAYER; }

__device__ __forceinline__ float wave_sum(float v) {
#pragma unroll
    for (int o = 1; o < 64; o <<= 1) v += __shfl_xor(v, o);
    return v;
}
__device__ __forceinline__ float wave_maxf(float v) {
#pragma unroll
    for (int o = 1; o < 64; o <<= 1) v = fmaxf(v, __shfl_xor(v, o));
    return v;
}
__device__ __forceinline__ float wave_incl_sum(float v, int lane) {
#pragma unroll
    for (int o = 1; o < 64; o <<= 1) { const float t = __shfl_up(v, o); if (lane >= o) v += t; }
    return v;
}
__device__ __forceinline__ float wave_incl_max(float v, int lane) {
#pragma unroll
    for (int o = 1; o < 64; o <<= 1) { const float t = __shfl_up(v, o); if (lane >= o) v = fmaxf(v, t); }
    return v;
}
__device__ __forceinline__ void lds_addf(LAS float* p, float v) { (void)__hip_atomic_fetch_add(p, v, __ATOMIC_RELAXED, __HIP_MEMORY_SCOPE_WORKGROUP); }
__device__ __forceinline__ float logsigmoidf_(float x) { return fminf(x, 0.f) - log1pf(__expf(-fabsf(x))); }

#define MFMA16(btf, af, c) __builtin_amdgcn_mfma_f32_16x16x32_bf16(btf, af, c, 0, 0, 0)
__device__ __forceinline__ bf16x8 ldl8(const LAS bf16* p) { return *(const LAS bf16x8*)p; }
__device__ __forceinline__ bf16x8 ldg8(const bf16* p) { return *(const GAS bf16x8*)p; }
__device__ __forceinline__ v2u pack4(f32x4 v) { v2u w; w.x = pk2(v[0], v[1]); w.y = pk2(v[2], v[3]); return w; }
__device__ __forceinline__ v4u pack8(const float (&o)[8]) { v4u w; w.x = pk2(o[0], o[1]); w.y = pk2(o[2], o[3]); w.z = pk2(o[4], o[5]); w.w = pk2(o[6], o[7]); return w; }

template <bool SILU> __device__ __forceinline__ void conv8(const bf16* pr, int pos, const float* w, int wstride, const float* bias, float (&o)[8], v4u& raw) {
    const f32x4 b0 = *(const GAS f32x4*)bias, b1 = *(const GAS f32x4*)(bias + 4);
    o[0] = b0[0]; o[1] = b0[1]; o[2] = b0[2]; o[3] = b0[3]; o[4] = b1[0]; o[5] = b1[1]; o[6] = b1[2]; o[7] = b1[3];
#pragma unroll
    for (int k = 0; k < 4; ++k) {
        v4u x = (v4u){0u, 0u, 0u, 0u};
        if (pos - 3 + k >= 0) x = *(const GAS v4u*)(pr + (k - 3) * NP);
        if (k == 3) raw = x;
        const f32x4 w0 = *(const GAS f32x4*)(w + k * wstride), w1 = *(const GAS f32x4*)(w + k * wstride + 4);
        o[0] += w0[0] * lo16(x.x); o[1] += w0[1] * hi16(x.x); o[2] += w0[2] * lo16(x.y); o[3] += w0[3] * hi16(x.y);
        o[4] += w1[0] * lo16(x.z); o[5] += w1[1] * hi16(x.z); o[6] += w1[2] * lo16(x.w); o[7] += w1[3] * hi16(x.w);
    }
    if (SILU) {
#pragma unroll
        for (int i = 0; i < 8; ++i) o[i] = siluf_(o[i]);
    }
}
template <bool SILU> __device__ __forceinline__ void conv_t8(const bf16* pc, int pos0, const float* w, int wstride, float bias, float (&o)[8]) {
    float x[11];
#pragma unroll
    for (int i = 0; i < 11; ++i) { x[i] = 0.f; if (pos0 + i - 3 >= 0) x[i] = bf2f((unsigned)*(const GAS bf16*)(pc + (i - 3) * NP)); }
    const float w0 = w[0], w1 = w[wstride], w2 = w[2 * wstride], w3 = w[3 * wstride];
#pragma unroll
    for (int i = 0; i < 8; ++i) { float v = bias + w0 * x[i] + w1 * x[i + 1] + w2 * x[i + 2] + w3 * x[i + 3]; o[i] = SILU ? siluf_(v) : v; }
}

template <bool SMALL> __device__ __forceinline__ void tr_item(const float* src, int ldw, int srccol0, int k0, bf16* dst, int ldo, int dstrow0, const float* gain, float scal, LAS float* scr, int lane) {
    const int nn = lane & 31;
    int sc = srccol0 + nn; bool ok = true;
    if (SMALL) { sc = nn < 8 ? 1024 + nn : 3592 + (nn - 8); ok = nn < 16; }
#pragma unroll 8
    for (int i = 0; i < 32; ++i) { const int kk = 2 * i + (lane >> 5); float v = 0.f;
        if (ok) v = *(const GAS float*)(src + (size_t)(k0 + kk) * ldw + sc) * (gain ? *(const GAS float*)(gain + k0 + kk) : 1.0f) * scal;
        scr[kk * 33 + nn] = v; }
    LDS_WAIT(); asm volatile("" ::: "memory");
    const int c = lane & 7;
#pragma unroll
    for (int j = 0; j < 4; ++j) { const int n = (lane >> 3) + 8 * j; const LAS float* s = scr + (8 * c) * 33 + n;
        v4u o; o.x = pk2(s[0 * 33], s[1 * 33]); o.y = pk2(s[2 * 33], s[3 * 33]); o.z = pk2(s[4 * 33], s[5 * 33]); o.w = pk2(s[6 * 33], s[7 * 33]);
        if (!SMALL || n < 16) *(GAS v4u*)(dst + (size_t)(dstrow0 + n) * ldo + k0 + 8 * c) = o; }
    LDS_WAIT(); asm volatile("" ::: "memory");
}
__device__ __forceinline__ int pcol_src(int n0) {
    if (n0 < 512) return n0;
    if (n0 < 1024) return 1032 + (n0 - 512);
    if (n0 < 2048) return 2568 + (n0 - 1024);
    if (n0 < 2560) return 512 + (n0 - 2048);
    if (n0 < 3072) return 1544 + (n0 - 2560);
    return 2056 + (n0 - 3072);
}
__device__ __forceinline__ void p0_prologue(const Frame& F) {
    LAS float* scr = (LAS float*)(F.lds + RING_OFF + F.wave * 16384);
    const int gw = F.vcu * NWAVES + F.wave, NGW = F.G * NWAVES;
    constexpr int I_IN = 16 * 113, I_VF = 1024 * 4, I_OUT = 24 * 32, I_UP = 16 * 176, I_DN = 44 * 32, I_QKV = 3 * 4 * 8, I_AX = 2 * 8 * 2, I_LAYER = I_IN + I_OUT + I_UP + I_DN + I_QKV + I_AX + I_VF;
    for (int it = gw; it < DEPTH * I_LAYER; it += NGW) {
        const int l = it / I_LAYER; int r = it - l * I_LAYER;
        bf16* W = (bf16*)(F.ws + WS_W) + (size_t)l * W_LAYER;
        if (r < I_IN) { const int kb = r / 113, nb = r % 113; const float* src = inp(F, 5) + (size_t)l * 1024 * 3600; const float* gain = inp(F, 1) + l * 1024;
            if (nb < 112) tr_item<false>(src, 3600, pcol_src(32 * nb), 64 * kb, W + W_IN, 1024, 32 * nb, gain, 1.0f, scr, F.lane);
            else tr_item<true>(src, 3600, 0, 64 * kb, W + W_IN, 1024, 4096, gain, 1.0f, scr, F.lane);
            continue; }
        r -= I_IN;
        if (r < I_OUT) { const int kb = r / 32, nb = r % 32; tr_item<false>(inp(F, 27) + (size_t)l * 1536 * 1024, 1024, 32 * nb, 64 * kb, W + W_OUT, 1536, 32 * nb, nullptr, 1.0f, scr, F.lane); continue; }
        r -= I_OUT;
        if (r < I_UP) { const int kb = r / 176, nb = r % 176, n0 = 32 * nb, pn = n0 >> 8, wi = n0 & 255; const int sc = wi < 128 ? 128 * pn + wi : 2816 + 128 * pn + (wi - 128);
            tr_item<false>(inp(F, 28) + (size_t)l * 1024 * 5632, 5632, sc, 64 * kb, W + W_UP, 1024, n0, inp(F, 3) + l * 1024, 1.0f, scr, F.lane); continue; }
        r -= I_UP;
        if (r < I_DN) { const int kb = r / 32, nb = r % 32; tr_item<false>(inp(F, 31) + (size_t)l * 2816 * 1024, 1024, 32 * nb, 64 * kb, W + W_DN, 2816, 32 * nb, nullptr, 1.0f, scr, F.lane); continue; }
        r -= I_DN;
        if (r < I_QKV) { const int which = r / 32, h = (r % 32) / 8, kb = (r % 8) / 4, nb = r % 4;
            const float* src = (which == 0 ? inp(F, 8) : which == 1 ? inp(F, 9) : inp(F, 10)) + ((size_t)l * 4 + h) * 16384;
            tr_item<false>(src, 128, 32 * nb, 64 * kb, W + W_Q + (size_t)which * 65536 + h * 16384, 128, 32 * nb, nullptr, which == 1 ? 0.08838834764831845f : 1.0f, scr, F.lane); continue; }
        r -= I_QKV;
        if (r < I_AX) { const int which = r / 16, n = (r % 16) / 2, nb = r % 2;
            const float* src = (which == 0 ? inp(F, 16) : inp(F, 18)) + ((size_t)l * 8 + n) * 4096;
            tr_item<false>(src, 64, 32 * nb, 0, W + (which == 0 ? W_A : W_X) + n * 4096, 64, 32 * nb, nullptr, 1.0f, scr, F.lane); continue; }
        r -= I_AX;
        {
            const int k = r >> 2, h = r & 3; const float* wi = inp(F, 5) + (size_t)l * 1024 * 3600 + (size_t)k * 3600 + h * 128; const float* wv = inp(F, 10) + ((size_t)l * 4 + h) * 16384;
            float a0 = 0.f, a1 = 0.f;
#pragma unroll 8
            for (int d = 0; d < 128; ++d) { const float x = *(const GAS float*)(wi + d); a0 += x * *(const GAS float*)(wv + d * 128 + F.lane); a1 += x * *(const GAS float*)(wv + d * 128 + 64 + F.lane); }
            const float g = *(const GAS float*)(inp(F, 1) + l * 1024 + k);
            bf16* dst = W + W_IN + (size_t)(3584 + h * 128) * 1024 + k;
            *(GAS bf16*)(dst + (size_t)F.lane * 1024) = (bf16)f2bf(a0 * g); *(GAS bf16*)(dst + (size_t)(F.lane + 64) * 1024) = (bf16)f2bf(a1 * g); }
    }
    bf16* XN = (bf16*)(F.ws + WS_XN);
    for (int m = gw; m < TOK; m += NGW) {
        const GAS f32x4* xr = (const GAS f32x4*)(inp(F, 0) + (size_t)m * DM) + F.lane;
        f32x4 v[4]; float s = 0.f;
#pragma unroll
        for (int j = 0; j < 4; ++j) { v[j] = xr[64 * j]; s += (v[j][0] * v[j][0] + v[j][1] * v[j][1]) + (v[j][2] * v[j][2] + v[j][3] * v[j][3]); }
        const float rs = 1.0f / sqrtf(wave_sum(s) * (1.0f / DM) + EPS);
        GAS v2u* o8 = (GAS v2u*)(XN + (size_t)m * DM) + F.lane;
#pragma unroll
        for (int j = 0; j < 4; ++j) { v2u w; w.x = pk2(v[j][0] * rs, v[j][1] * rs); w.y = pk2(v[j][2] * rs, v[j][3] * rs); o8[64 * j] = w; }
    }
}

__device__ __forceinline__ void small_cols(const Frame& F, int l) {
    const bf16* XN = (const bf16*)(F.ws + WS_XN); const bf16* Ws = wlayer(F, l) + W_IN + (size_t)4096 * 1024; float* PS = (float*)(F.ws + WS_PS);
    const int q = F.lane >> 4, i = F.lane & 15;
    for (int rb = blockIdx.x * NWAVES + F.wave; rb < TOK / 16; rb += F.G * NWAVES) {
        const bf16* ap = XN + (size_t)(rb * 16 + i) * DM + 8 * q; const bf16* bp = Ws + (size_t)i * DM + 8 * q;
        f32x4 acc = (f32x4){0.f, 0.f, 0.f, 0.f};
#pragma unroll 8
        for (int kk = 0; kk < 32; ++kk) acc = MFMA16(ldg8(bp + 32 * kk), ldg8(ap + 32 * kk), acc);
        *(GAS f32x4*)(PS + (size_t)(rb * 16 + i) * 16 + 4 * q) = acc;
    }
}
template <bool SC> __device__ __forceinline__ void load_T(const bf16* X, LAS bf16* OT, const LAS float* sc, int ncg, int tid) {
    for (int u = tid; u < ncg * 64; u += NTHR) { const int t = u & 63, cg = u >> 6;
        const v4u w = *(const GAS v4u*)(X + (size_t)t * NP + cg * 8);
        float f[8] = {lo16(w.x), hi16(w.x), lo16(w.y), hi16(w.y), lo16(w.z), hi16(w.z), lo16(w.w), hi16(w.w)};
        LAS bf16* o = OT + (cg * 8) * 72 + t;
        if (SC) { const float s = sc[t * 4 + (cg >> 3)];
#pragma unroll
            for (int j = 0; j < 8; ++j) o[j * 72] = (bf16)f2bf(f[j] * s); }
        else { o[0] = (bf16)(w.x & 0xffffu); o[72] = (bf16)(w.x >> 16); o[144] = (bf16)(w.y & 0xffffu); o[216] = (bf16)(w.y >> 16);
               o[288] = (bf16)(w.z & 0xffffu); o[360] = (bf16)(w.z >> 16); o[432] = (bf16)(w.w & 0xffffu); o[504] = (bf16)(w.w >> 16); } }
}

template <bool SCALE> __device__ __forceinline__ void proj_T(const bf16* WT, const bf16* X, LAS bf16* OT, const LAS float* sc, int ft, int lane) {
    const int q = lane >> 4, i = lane & 15;
    bf16x8 af[4];
#pragma unroll
    for (int kk = 0; kk < 4; ++kk) af[kk] = ldg8(WT + (size_t)(ft * 16 + i) * 128 + 8 * q + 32 * kk);
#pragma unroll
    for (int st = 0; st < 4; ++st) { f32x4 acc = (f32x4){0.f, 0.f, 0.f, 0.f};
#pragma unroll
        for (int kk = 0; kk < 4; ++kk) acc = MFMA16(ldg8(X + (size_t)(st * 16 + i) * NP + 8 * q + 32 * kk), af[kk], acc);
        if (SCALE) { const f32x4 s4 = *(const LAS f32x4*)(sc + st * 16 + 4 * q); acc = acc * s4; }
        *(LAS v2u*)(OT + (ft * 16 + i) * 72 + st * 16 + 4 * q) = pack4(acc); }
}
__device__ __forceinline__ void proj_R(const bf16* WT, const bf16* X, LAS bf16* O, int ft, int lane) {
    const int q = lane >> 4, i = lane & 15;
    bf16x8 bf[4];
#pragma unroll
    for (int kk = 0; kk < 4; ++kk) bf[kk] = ldg8(WT + (size_t)(ft * 16 + i) * 128 + 8 * q + 32 * kk);
#pragma unroll
    for (int st = 0; st < 4; ++st) { f32x4 acc = (f32x4){0.f, 0.f, 0.f, 0.f};
#pragma unroll
        for (int kk = 0; kk < 4; ++kk) acc = MFMA16(bf[kk], ldg8(X + (size_t)(st * 16 + i) * NP + 8 * q + 32 * kk), acc);
        *(LAS v2u*)(O + (st * 16 + i) * 136 + ft * 16 + 4 * q) = pack4(acc); }
}
__device__ __forceinline__ void mlstm_local(const Frame& F, int l, int item) {
    const int c = item & 63, bh = item >> 6, h = bh & 3, b = bh >> 2, lane = F.lane, q = lane >> 4, i = lane & 15;
    LAS bf16* EKT = (LAS bf16*)F.lds; LAS bf16* VT = EKT + 128 * 72; LAS float* EW = (LAS float*)(VT + 128 * 72);
    float* MS = (float*)(F.ws + WS_MS);
    const bf16* Pt = (const bf16*)(F.ws + WS_P) + (size_t)(b * SEQ + c * 64) * NP;
    load_T<false>(Pt + PC_V + h * 128, VT, EW, 16, F.tid);
    if (F.wave == 0) {
        const float* PS = (const float*)(F.ws + WS_PS) + (size_t)(b * SEQ + c * 64 + lane) * 16;
        const float li = *(const GAS float*)(PS + h) + inp(F, 11)[l * 4 + h], lf = logsigmoidf_(*(const GAS float*)(PS + 4 + h) + inp(F, 12)[l * 4 + h]);
        const float bc = wave_incl_sum(lf, lane), bt = __shfl(bc, 63), w = bt - bc + li, ml = wave_maxf(w);
        EW[lane] = __expf(w - ml);
        if (lane == 0) { MS[item] = ml; MS[2048 + item] = bt; }
    }
    __syncthreads();
    proj_T<true>(wlayer(F, l) + W_K + h * 16384, Pt + PC_XC + h * 128, EKT, EW, F.wave, lane);
    __syncthreads();
    {
        bf16* CT = (bf16*)(F.ws + WS_MC) + (size_t)item * 16384;
        bf16x8 af[2];
#pragma unroll
        for (int kk = 0; kk < 2; ++kk) af[kk] = ldl8(VT + (F.wave * 16 + i) * 72 + 8 * q + 32 * kk);
#pragma unroll
        for (int dt = 0; dt < 8; ++dt) { f32x4 acc = (f32x4){0.f, 0.f, 0.f, 0.f};
#pragma unroll
            for (int kk = 0; kk < 2; ++kk) acc = MFMA16(ldl8(EKT + (dt * 16 + i) * 72 + 8 * q + 32 * kk), af[kk], acc);
            *(GAS v2u*)(CT + (size_t)(F.wave * 16 + i) * 128 + dt * 16 + 4 * q) = pack4(acc); }
        if (F.tid < 128) { float s = 0.f;
#pragma unroll
            for (int j = 0; j < 8; ++j) { const v4u w = *(const LAS v4u*)(EKT + F.tid * 72 + 8 * j); s += (lo16(w.x) + hi16(w.x)) + (lo16(w.y) + hi16(w.y)) + (lo16(w.z) + hi16(w.z)) + (lo16(w.w) + hi16(w.w)); }
            *(GAS float*)((float*)(F.ws + WS_MN) + (size_t)item * 128 + F.tid) = s; }
    }
    __syncthreads();
}
__device__ __forceinline__ void mlstm_out(const Frame& F, int l, int item) {
    const int c = item & 63, bh = item >> 6, h = bh & 3, b = bh >> 2, lane = F.lane, q = lane >> 4, i = lane & 15;
    LAS bf16* Q = (LAS bf16*)F.lds; LAS bf16* K = Q + 64 * 136; LAS bf16* VT = K + 64 * 136; LAS bf16* SC = VT + 128 * 72;
    LAS float* GV = (LAS float*)(SC + 64 * 72); LAS float* AL = GV + 64; LAS float* EI = AL + 64; LAS float* EM = EI + 64; LAS float* DEN = EM + 64; LAS float* QN = DEN + 64; LAS float* SS = QN + 64;
    const float* MS = (const float*)(F.ws + WS_MS);
    const bf16* Pt = (const bf16*)(F.ws + WS_P) + (size_t)(b * SEQ + c * 64) * NP;
    load_T<false>(Pt + PC_V + h * 128, VT, GV, 16, F.tid);
    if (F.wave == 0) {
        const float* PS = (const float*)(F.ws + WS_PS) + (size_t)(b * SEQ + c * 64 + lane) * 16;
        const float li = *(const GAS float*)(PS + h) + inp(F, 11)[l * 4 + h], lf = logsigmoidf_(*(const GAS float*)(PS + 4 + h) + inp(F, 12)[l * 4 + h]);
        const float bc = wave_incl_sum(lf, lane), g = li - bc, pm = wave_incl_max(g, lane), mst = *(const GAS float*)(MS + 4096 + item);
        const float il = bc + mst, mt = fmaxf(il, bc + pm);
        GV[lane] = g; AL[lane] = bc - mt; EI[lane] = __expf(il - mt); EM[lane] = __expf(-mt); DEN[lane] = 0.f; SS[lane] = 0.f;
    }
    const bf16* W = wlayer(F, l);
    proj_R(W + W_Q + h * 16384, Pt + PC_XC + h * 128, Q, F.wave, lane);
    proj_R(W + W_K + h * 16384, Pt + PC_XC + h * 128, K, F.wave, lane);
    __syncthreads();
    {
#pragma unroll
        for (int r2 = 0; r2 < 2; ++r2) { const int tile = F.wave + 8 * r2, tt = tile >> 2, st = tile & 3;
            f32x4 acc = (f32x4){0.f, 0.f, 0.f, 0.f};
            if (st <= tt) {
#pragma unroll
                for (int kk = 0; kk < 4; ++kk) acc = MFMA16(ldl8(K + (st * 16 + i) * 136 + 8 * q + 32 * kk), ldl8(Q + (tt * 16 + i) * 136 + 8 * q + 32 * kk), acc);
                const int t = tt * 16 + i; const float al = AL[t]; const f32x4 g4 = *(const LAS f32x4*)(GV + st * 16 + 4 * q); float rs = 0.f;
#pragma unroll
                for (int r = 0; r < 4; ++r) { const int s = st * 16 + 4 * q + r; const float f = (s <= t) ? __expf(al + g4[r]) : 0.f; acc[r] *= f; rs += acc[r]; }
                rs += __shfl_xor(rs, 16); rs += __shfl_xor(rs, 32);
                if (q == 0) lds_addf(DEN + t, rs);
            }
            *(LAS v2u*)(SC + (tt * 16 + i) * 72 + st * 16 + 4 * q) = pack4(acc); }
        { const int t = F.tid >> 3, part = F.tid & 7; const float* NS = (const float*)(F.ws + WS_MN) + (size_t)item * 128 + part * 16;
          const v4u w0 = *(const LAS v4u*)(Q + t * 136 + part * 16), w1 = *(const LAS v4u*)(Q + t * 136 + part * 16 + 8);
          const f32x4 n0 = *(const GAS f32x4*)NS, n1 = *(const GAS f32x4*)(NS + 4), n2 = *(const GAS f32x4*)(NS + 8), n3 = *(const GAS f32x4*)(NS + 12);
          float s = lo16(w0.x) * n0[0] + hi16(w0.x) * n0[1] + lo16(w0.y) * n0[2] + hi16(w0.y) * n0[3] + lo16(w0.z) * n1[0] + hi16(w0.z) * n1[1] + lo16(w0.w) * n1[2] + hi16(w0.w) * n1[3]
                  + lo16(w1.x) * n2[0] + hi16(w1.x) * n2[1] + lo16(w1.y) * n2[2] + hi16(w1.y) * n2[3] + lo16(w1.z) * n3[0] + hi16(w1.z) * n3[1] + lo16(w1.w) * n3[2] + hi16(w1.w) * n3[3];
          s += __shfl_xor(s, 1); s += __shfl_xor(s, 2); s += __shfl_xor(s, 4);
          if (part == 0) QN[t] = s; }
    }
    __syncthreads();
    f32x4 hv[4];
    bf16* Pm = (bf16*)(F.ws + WS_P) + (size_t)(b * SEQ + c * 64) * NP + PC_OM + h * 128;
    {
        const bf16* CT = (const bf16*)(F.ws + WS_MC) + (size_t)item * 16384;
        const int e0 = F.wave * 16;
        bf16x8 vf[2], cf[4];
#pragma unroll
        for (int kk = 0; kk < 2; ++kk) vf[kk] = ldl8(VT + (e0 + i) * 72 + 8 * q + 32 * kk);
#pragma unroll
        for (int kk = 0; kk < 4; ++kk) cf[kk] = ldg8(CT + (size_t)(e0 + i) * 128 + 8 * q + 32 * kk);
#pragma unroll
        for (int tt = 0; tt < 4; ++tt) { f32x4 a1 = (f32x4){0.f, 0.f, 0.f, 0.f}, a2 = (f32x4){0.f, 0.f, 0.f, 0.f};
#pragma unroll
            for (int kk = 0; kk < 2; ++kk) a1 = MFMA16(vf[kk], ldl8(SC + (tt * 16 + i) * 72 + 8 * q + 32 * kk), a1);
#pragma unroll
            for (int kk = 0; kk < 4; ++kk) a2 = MFMA16(cf[kk], ldl8(Q + (tt * 16 + i) * 136 + 8 * q + 32 * kk), a2);
            const int t = tt * 16 + i; const float ei = EI[t], den = DEN[t] + ei * QN[t], inv = 1.0f / fmaxf(fabsf(den), EM[t]);
            const v2u ow = *(const GAS v2u*)(Pm + (size_t)t * NP + e0 + 4 * q);
            f32x4 o; o[0] = sigmoidf_(lo16(ow.x)); o[1] = sigmoidf_(hi16(ow.x)); o[2] = sigmoidf_(lo16(ow.y)); o[3] = sigmoidf_(hi16(ow.y));
            float ss = 0.f;
#pragma unroll
            for (int r = 0; r < 4; ++r) { const float v = (a1[r] + ei * a2[r]) * inv * o[r]; hv[tt][r] = v; ss += v * v; }
            ss += __shfl_xor(ss, 16); ss += __shfl_xor(ss, 32);
            if (q == 0) lds_addf(SS + t, ss); }
    }
    __syncthreads();
    { const f32x4 gn = *(const GAS f32x4*)(inp(F, 13) + l * 512 + h * 128 + F.wave * 16 + 4 * q);
#pragma unroll
      for (int tt = 0; tt < 4; ++tt) { const int t = tt * 16 + i; const float rn = 1.0f / sqrtf(SS[t] * (1.0f / 128.0f) + EPS);
          *(GAS v2u*)(Pm + (size_t)t * NP + F.wave * 16 + 4 * q) = pack4(hv[tt] * rn * gn); } }
    __syncthreads();
}

__device__ __forceinline__ void ssd_gates(const Frame& F, int l, int b, int c, int g, LAS float* DT, LAS float* ACUM, float& dt, float& acum, float& alast) {
    const int hh = F.wave, h = 4 * g + hh, lane = F.lane;
    const float raw = *(const GAS float*)((const float*)(F.ws + WS_PS) + (size_t)(b * SEQ + c * 64 + lane) * 16 + 8 + h);
    dt = softplusf_(raw + inp(F, 23)[l * 8 + h]);
    const float a = -dt * __expf(inp(F, 24)[l * 8 + h]);
    acum = wave_incl_sum(a, lane); alast = __shfl(acum, 63);
    DT[lane * 4 + hh] = dt; ACUM[lane * 4 + hh] = acum;
}
__device__ __forceinline__ void ssd_local(const Frame& F, int l, int item) {
    const int g = item & 1, bc = item >> 1, c = bc & 63, b = bc >> 6, lane = F.lane, q = lane >> 4, i = lane & 15;
    LAS bf16* XWT = (LAS bf16*)F.lds; LAS bf16* BMT = XWT + 256 * 72; LAS float* DTW = (LAS float*)(BMT + 128 * 72); LAS float* ACUM = DTW + 256;
    float* DEC = (float*)(F.ws + WS_MS) + 8192;
    const bf16* Pt = (const bf16*)(F.ws + WS_P) + (size_t)(b * SEQ + c * 64) * NP + PC_XBC;
    load_T<false>(Pt + 512 + g * 128, BMT, DTW, 16, F.tid);
    if (F.wave < 4) { float dt, acum, alast; ssd_gates(F, l, b, c, g, DTW, ACUM, dt, acum, alast);
        DTW[lane * 4 + F.wave] = dt * __expf(alast - acum);
        if (lane == 63) *(GAS float*)(DEC + ((size_t)(b * 8 + 4 * g + F.wave) * 64 + c)) = __expf(alast); }
    __syncthreads();
    load_T<true>(Pt + g * 256, XWT, DTW, 32, F.tid);
    __syncthreads();
    {
        bf16* SST = (bf16*)(F.ws + WS_SS);
#pragma unroll
        for (int mi = 0; mi < 2; ++mi) { const int mt = 2 * F.wave + mi, hp = mt * 16 + i, hh = hp >> 6, p = hp & 63;
            bf16x8 af[2];
#pragma unroll
            for (int kk = 0; kk < 2; ++kk) af[kk] = ldl8(XWT + hp * 72 + 8 * q + 32 * kk);
            bf16* dst = SST + ((size_t)((b * 8 + 4 * g + hh) * 64 + c)) * 8192 + (size_t)p * 128;
#pragma unroll
            for (int nt = 0; nt < 8; ++nt) { f32x4 acc = (f32x4){0.f, 0.f, 0.f, 0.f};
#pragma unroll
                for (int kk = 0; kk < 2; ++kk) acc = MFMA16(ldl8(BMT + (nt * 16 + i) * 72 + 8 * q + 32 * kk), af[kk], acc);
                *(GAS v2u*)(dst + nt * 16 + 4 * q) = pack4(acc); } }
    }
    __syncthreads();
}
__device__ __forceinline__ void ssd_out(const Frame& F, int l, int item) {
    const int c = item & 63, b = item >> 6, lane = F.lane, q = lane >> 4, i = lane & 15;
    LAS bf16* XDT = (LAS bf16*)F.lds; LAS bf16* CB = XDT + 256 * 72;
    LAS float* DT = (LAS float*)(CB + 4 * 64 * 72); LAS float* ACUM = DT + 256; LAS float* SS = ACUM + 256;
    const bf16* Pt = (const bf16*)(F.ws + WS_P) + (size_t)(b * SEQ + c * 64) * NP + PC_XBC;
    bf16* Pz = (bf16*)(F.ws + WS_P) + (size_t)(b * SEQ + c * 64) * NP + PC_ZS;
    if (F.tid < 64) SS[F.tid] = 0.f;
#pragma unroll 1
    for (int g = 0; g < 2; ++g) {
        const bf16* PB = Pt + 512 + g * 128; const bf16* PC = Pt + 768 + g * 128;
        if (F.wave < 4) { float dt, acum, alast; ssd_gates(F, l, b, c, g, DT, ACUM, dt, acum, alast); }
        __syncthreads();
        load_T<true>(Pt + g * 256, XDT, DT, 32, F.tid);
        {
#pragma unroll
            for (int r2 = 0; r2 < 2; ++r2) { const int tile = F.wave + 8 * r2, lt = tile >> 2, st = tile & 3;
                f32x4 acc = (f32x4){0.f, 0.f, 0.f, 0.f};
                if (st <= lt) {
#pragma unroll
                    for (int kk = 0; kk < 4; ++kk) acc = MFMA16(ldg8(PB + (size_t)(st * 16 + i) * NP + 8 * q + 32 * kk), ldg8(PC + (size_t)(lt * 16 + i) * NP + 8 * q + 32 * kk), acc); }
                const int tl = lt * 16 + i;
#pragma unroll
                for (int hh = 0; hh < 4; ++hh) { f32x4 v = (f32x4){0.f, 0.f, 0.f, 0.f};
                    if (st <= lt) { const float al = ACUM[tl * 4 + hh], dsk = inp(F, 25)[l * 8 + 4 * g + hh] / DT[tl * 4 + hh];
#pragma unroll
                        for (int r = 0; r < 4; ++r) { const int s = st * 16 + 4 * q + r; float f = (s <= tl) ? acc[r] * __expf(al - ACUM[s * 4 + hh]) : 0.f; if (s == tl) f += dsk; v[r] = f; } }
                    *(LAS v2u*)(CB + hh * 64 * 72 + tl * 72 + st * 16 + 4 * q) = pack4(v); } }
        }
        __syncthreads();
        {
            const int hh = F.wave >> 1, h = 4 * g + hh;
            const bf16* SST = (const bf16*)(F.ws + WS_SS) + ((size_t)((b * 8 + h) * 64 + c)) * 8192;
#pragma unroll
            for (int pi = 0; pi < 2; ++pi) { const int pt = 2 * (F.wave & 1) + pi;
                bf16x8 xf[2], sf[4];
#pragma unroll
                for (int kk = 0; kk < 2; ++kk) xf[kk] = ldl8(XDT + (hh * 64 + pt * 16 + i) * 72 + 8 * q + 32 * kk);
#pragma unroll
                for (int kk = 0; kk < 4; ++kk) sf[kk] = ldg8(SST + (size_t)(pt * 16 + i) * 128 + 8 * q + 32 * kk);
#pragma unroll
                for (int lt = 0; lt < 4; ++lt) { f32x4 a1 = (f32x4){0.f, 0.f, 0.f, 0.f}, a2 = (f32x4){0.f, 0.f, 0.f, 0.f};
#pragma unroll
                    for (int kk = 0; kk < 2; ++kk) a1 = MFMA16(xf[kk], ldl8(CB + hh * 64 * 72 + (lt * 16 + i) * 72 + 8 * q + 32 * kk), a1);
#pragma unroll
                    for (int kk = 0; kk < 4; ++kk) a2 = MFMA16(sf[kk], ldg8(PC + (size_t)(lt * 16 + i) * NP + 8 * q + 32 * kk), a2);
                    const int tl = lt * 16 + i; const float ea = __expf(ACUM[tl * 4 + hh]);
                    const v2u zw = *(const GAS v2u*)(Pz + (size_t)tl * NP + h * 64 + pt * 16 + 4 * q);
                    f32x4 z; z[0] = siluf_(lo16(zw.x)); z[1] = siluf_(hi16(zw.x)); z[2] = siluf_(lo16(zw.y)); z[3] = siluf_(hi16(zw.y));
                    float ss = 0.f; f32x4 yo;
#pragma unroll
                    for (int r = 0; r < 4; ++r) { const float v = (a1[r] + ea * a2[r]) * z[r]; yo[r] = v; ss += v * v; }
                    *(GAS v2u*)(Pz + (size_t)tl * NP + h * 64 + pt * 16 + 4 * q) = pack4(yo);
                    ss += __shfl_xor(ss, 16); ss += __shfl_xor(ss, 32);
                    if (q == 0) lds_addf(SS + tl, ss); } }
        }
        __syncthreads();
    }
    {
#pragma unroll
        for (int g = 0; g < 2; ++g) { const int hh = F.wave >> 1, h = 4 * g + hh;
#pragma unroll
            for (int pi = 0; pi < 2; ++pi) { const int pt = 2 * (F.wave & 1) + pi; const f32x4 gn = *(const GAS f32x4*)(inp(F, 26) + l * 512 + h * 64 + pt * 16 + 4 * q);
#pragma unroll
                for (int lt = 0; lt < 4; ++lt) { const int tl = lt * 16 + i; const float rn = 1.0f / sqrtf(SS[tl] * (1.0f / 512.0f) + EPS);
                    GAS v2u* dp = (GAS v2u*)(Pz + (size_t)tl * NP + h * 64 + pt * 16 + 4 * q); const v2u w = *dp;
                    f32x4 y; y[0] = lo16(w.x); y[1] = hi16(w.x); y[2] = lo16(w.y); y[3] = hi16(w.y);
                    *dp = pack4(y * rn * gn); } } }
    }
    __syncthreads();
}

template <bool OUT> __device__ __forceinline__ void rglru_item(const Frame& F, int l, int item) {
    const int half = item & 1, bc = item >> 1, c = bc & 63, b = bc >> 6, lane = F.lane, q = lane >> 4, i = lane & 15, ch0 = half * 256;
    LAS bf16* LA = (LAS bf16*)F.lds; LAS bf16* GI = LA + 64 * 264; LAS bf16* YB = GI + 64 * 264; LAS float* SP = (LAS float*)(YB + 64 * 264);
    const bf16* Px = (const bf16*)(F.ws + WS_P) + (size_t)(b * SEQ + c * 64) * NP + PC_XR + ch0;
    bf16* Py = (bf16*)(F.ws + WS_P) + (size_t)(b * SEQ + c * 64) * NP + PC_YR + ch0;
    if (F.tid < 256) SP[F.tid] = softplusf_(-inp(F, 20)[l * 512 + ch0 + F.tid]);
    if (OUT) {
#pragma unroll
        for (int it = 0; it < 4; ++it) { const int u = F.tid + NTHR * it, t = u >> 5, cg = u & 31; const v4u w = *(const GAS v4u*)(Py + (size_t)t * NP + cg * 8);
            float o[8] = {pg8::gelu_tanh(lo16(w.x)), pg8::gelu_tanh(hi16(w.x)), pg8::gelu_tanh(lo16(w.y)), pg8::gelu_tanh(hi16(w.y)), pg8::gelu_tanh(lo16(w.z)), pg8::gelu_tanh(hi16(w.z)), pg8::gelu_tanh(lo16(w.w)), pg8::gelu_tanh(hi16(w.w))};
            *(LAS v4u*)(YB + t * 264 + cg * 8) = pack8(o); } }
    __syncthreads();
    {
        const int gate = F.wave >> 2, blk = F.wave & 3;
        const bf16* WT = wlayer(F, l) + (gate == 0 ? W_A : W_X) + (size_t)(half * 4 + blk) * 4096;
        const float* bias = (gate == 0 ? inp(F, 17) : inp(F, 19)) + l * 512 + ch0 + blk * 64;
        bf16x8 af[4][2];
#pragma unroll
        for (int tt = 0; tt < 4; ++tt)
#pragma unroll
            for (int kk = 0; kk < 2; ++kk) af[tt][kk] = ldg8(Px + (size_t)(tt * 16 + i) * NP + blk * 64 + 8 * q + 32 * kk);
#pragma unroll
        for (int et = 0; et < 4; ++et) { bf16x8 bf[2];
#pragma unroll
            for (int kk = 0; kk < 2; ++kk) bf[kk] = ldg8(WT + (size_t)(et * 16 + i) * 64 + 8 * q + 32 * kk);
            const f32x4 b4 = *(const GAS f32x4*)(bias + et * 16 + 4 * q); const int chl = blk * 64 + et * 16 + 4 * q;
            const f32x4 sp4 = *(const LAS f32x4*)(SP + chl);
#pragma unroll
            for (int tt = 0; tt < 4; ++tt) { f32x4 acc = (f32x4){0.f, 0.f, 0.f, 0.f};
#pragma unroll
                for (int kk = 0; kk < 2; ++kk) acc = MFMA16(bf[kk], af[tt][kk], acc);
                const int t = tt * 16 + i; f32x4 o;
                if (gate == 0) {
#pragma unroll
                    for (int r = 0; r < 4; ++r) o[r] = -8.0f * sigmoidf_(acc[r] + b4[r]) * sp4[r];
                    *(LAS v2u*)(LA + t * 264 + chl) = pack4(o);
                } else { const v2u xw = *(const GAS v2u*)(Px + (size_t)t * NP + chl);
                    o[0] = sigmoidf_(acc[0] + b4[0]) * lo16(xw.x); o[1] = sigmoidf_(acc[1] + b4[1]) * hi16(xw.x); o[2] = sigmoidf_(acc[2] + b4[2]) * lo16(xw.y); o[3] = sigmoidf_(acc[3] + b4[3]) * hi16(xw.y);
                    *(LAS v2u*)(GI + t * 264 + chl) = pack4(o); } } }
    }
    __syncthreads();
    float* RG = (float*)(F.ws + WS_RG);
    if (F.tid < 256) { const int ch = F.tid;
        float hs = OUT ? *(const GAS float*)(RG + (size_t)item * 256 + ch) : 0.f, ap = 1.0f;
#pragma unroll 8
        for (int t = 0; t < 64; ++t) { const float la = bf2f((unsigned)LA[t * 264 + ch]), gi = bf2f((unsigned)GI[t * 264 + ch]);
            const float a = __expf(la), mult = sqrtf(fmaxf(1.0f - a * a, 0.f));
            hs = a * hs + mult * gi; ap *= a;
            if (OUT) YB[t * 264 + ch] = (bf16)f2bf(hs * bf2f((unsigned)YB[t * 264 + ch])); }
        if (!OUT) { *(GAS float*)(RG + (size_t)item * 256 + ch) = ap; *(GAS float*)(RG + 262144 + (size_t)item * 256 + ch) = hs; } }
    __syncthreads();
    if (OUT) {
#pragma unroll
        for (int it = 0; it < 4; ++it) { const int u = F.tid + NTHR * it, t = u >> 5, cg = u & 31; *(GAS v4u*)(Py + (size_t)t * NP + cg * 8) = *(const LAS v4u*)(YB + t * 264 + cg * 8); }
        __syncthreads(); }
}

__device__ __forceinline__ void scans(const Frame& F) {
    const int gt = F.vcu * NTHR + F.tid, NT = F.G * NTHR;
    float* MS = (float*)(F.ws + WS_MS);
    for (int job = gt; job < 32 * 2048; job += NT) { const int sq = job >> 11, grp = job & 2047;
        bf16* p = (bf16*)(F.ws + WS_MC) + (size_t)sq * 64 * 16384 + grp * 8;
        float st[8]; float m = 0.f;
#pragma unroll
        for (int j = 0; j < 8; ++j) st[j] = 0.f;
#pragma unroll 1
        for (int c0 = 0; c0 < 64; c0 += 8) { v4u v[8];
#pragma unroll
            for (int k = 0; k < 8; ++k) v[k] = *(const GAS v4u*)(p + (size_t)(c0 + k) * 16384);
#pragma unroll
            for (int k = 0; k < 8; ++k) { const int it = sq * 64 + c0 + k; const float ml = *(const GAS float*)(MS + it), bt = *(const GAS float*)(MS + 2048 + it);
                const float mn = fmaxf(bt + m, ml), sp = __expf(bt + m - mn), sl = __expf(ml - mn);
                if (grp == 0) *(GAS float*)(MS + 4096 + it) = m;
                v4u o; o.x = pk2(st[0], st[1]); o.y = pk2(st[2], st[3]); o.z = pk2(st[4], st[5]); o.w = pk2(st[6], st[7]);
                *(GAS v4u*)(p + (size_t)(c0 + k) * 16384) = o;
                st[0] = sp * st[0] + sl * lo16(v[k].x); st[1] = sp * st[1] + sl * hi16(v[k].x); st[2] = sp * st[2] + sl * lo16(v[k].y); st[3] = sp * st[3] + sl * hi16(v[k].y);
                st[4] = sp * st[4] + sl * lo16(v[k].z); st[5] = sp * st[5] + sl * hi16(v[k].z); st[6] = sp * st[6] + sl * lo16(v[k].w); st[7] = sp * st[7] + sl * hi16(v[k].w);
                m = mn; } } }
    for (int job = gt; job < 64 * 1024; job += NT) { const int sq = job >> 10, grp = job & 1023;
        bf16* p = (bf16*)(F.ws + WS_SS) + (size_t)sq * 64 * 8192 + grp * 8;
        float st[8];
#pragma unroll
        for (int j = 0; j < 8; ++j) st[j] = 0.f;
#pragma unroll 1
        for (int c0 = 0; c0 < 64; c0 += 8) { v4u v[8];
#pragma unroll
            for (int k = 0; k < 8; ++k) v[k] = *(const GAS v4u*)(p + (size_t)(c0 + k) * 8192);
#pragma unroll
            for (int k = 0; k < 8; ++k) { const float dc = *(const GAS float*)(MS + 8192 + sq * 64 + c0 + k);
                v4u o; o.x = pk2(st[0], st[1]); o.y = pk2(st[2], st[3]); o.z = pk2(st[4], st[5]); o.w = pk2(st[6], st[7]);
                *(GAS v4u*)(p + (size_t)(c0 + k) * 8192) = o;
                st[0] = dc * st[0] + lo16(v[k].x); st[1] = dc * st[1] + hi16(v[k].x); st[2] = dc * st[2] + lo16(v[k].y); st[3] = dc * st[3] + hi16(v[k].y);
                st[4] = dc * st[4] + lo16(v[k].z); st[5] = dc * st[5] + hi16(v[k].z); st[6] = dc * st[6] + lo16(v[k].w); st[7] = dc * st[7] + hi16(v[k].w); } } }
    for (int job = gt; job < 32 * 128; job += NT) { const int sq = job >> 7, e = job & 127; float* p = (float*)(F.ws + WS_MN) + (size_t)sq * 64 * 128 + e; float st = 0.f, m = 0.f;
#pragma unroll 1
        for (int c0 = 0; c0 < 64; c0 += 16) { float v[16], ml[16], bt[16];
#pragma unroll
            for (int k = 0; k < 16; ++k) { const int it = sq * 64 + c0 + k; v[k] = *(const GAS float*)(p + (c0 + k) * 128); ml[k] = *(const GAS float*)(MS + it); bt[k] = *(const GAS float*)(MS + 2048 + it); }
#pragma unroll
            for (int k = 0; k < 16; ++k) { const float mn = fmaxf(bt[k] + m, ml[k]), sp = __expf(bt[k] + m - mn), sl = __expf(ml[k] - mn);
                *(GAS float*)(p + (c0 + k) * 128) = st; st = sp * st + sl * v[k]; m = mn; } } }
    for (int job = gt; job < 8 * 512; job += NT) { const int b = job >> 9, half = (job >> 8) & 1, ch = job & 255; float* RG = (float*)(F.ws + WS_RG); float h = 0.f;
#pragma unroll 1
        for (int c0 = 0; c0 < 64; c0 += 16) { float a[16], u[16];
#pragma unroll
            for (int k = 0; k < 16; ++k) { const size_t o = (size_t)(((b * 64 + c0 + k) * 2 + half)) * 256 + ch; a[k] = *(const GAS float*)(RG + o); u[k] = *(const GAS float*)(RG + 262144 + o); }
#pragma unroll
            for (int k = 0; k < 16; ++k) { const size_t o = (size_t)(((b * 64 + c0 + k) * 2 + half)) * 256 + ch; *(GAS float*)(RG + o) = h; h = a[k] * h + u[k]; } } }
}

__device__ __forceinline__ void rms_update(const Frame& F, const float* xold, float* xnew, const float* g, bool write_xn) {
    const int gw = F.vcu * NWAVES + F.wave, NGW = F.G * NWAVES;
    const float* Y = (const float*)(F.ws + WS_Y); bf16* XN = (bf16*)(F.ws + WS_XN);
    f32x4 gv[4];
#pragma unroll
    for (int j = 0; j < 4; ++j) gv[j] = *((const GAS f32x4*)g + F.lane + 64 * j);
    for (int m = gw; m < TOK; m += NGW) {
        const GAS f32x4* yr = (const GAS f32x4*)(Y + (size_t)m * DM) + F.lane; const GAS f32x4* xr = (const GAS f32x4*)(xold + (size_t)m * DM) + F.lane;
        f32x4 y[4], x[4]; float s = 0.f;
#pragma unroll
        for (int j = 0; j < 4; ++j) { y[j] = yr[64 * j]; x[j] = xr[64 * j]; s += (y[j][0] * y[j][0] + y[j][1] * y[j][1]) + (y[j][2] * y[j][2] + y[j][3] * y[j][3]); }
        const float r1 = 1.0f / sqrtf(wave_sum(s) * (1.0f / DM) + EPS); float s2 = 0.f;
#pragma unroll
        for (int j = 0; j < 4; ++j) { x[j] = x[j] + y[j] * r1 * gv[j]; s2 += (x[j][0] * x[j][0] + x[j][1] * x[j][1]) + (x[j][2] * x[j][2] + x[j][3] * x[j][3]); }
        GAS f32x4* xo = (GAS f32x4*)(xnew + (size_t)m * DM) + F.lane;
#pragma unroll
        for (int j = 0; j < 4; ++j) xo[64 * j] = x[j];
        if (write_xn) { const float r2 = 1.0f / sqrtf(wave_sum(s2) * (1.0f / DM) + EPS); GAS v2u* o8 = (GAS v2u*)(XN + (size_t)m * DM) + F.lane;
#pragma unroll
            for (int j = 0; j < 4; ++j) { v2u w; w.x = pk2(x[j][0] * r2, x[j][1] * r2); w.y = pk2(x[j][2] * r2, x[j][3] * r2); o8[64 * j] = w; } }
    }
}
__device__ __forceinline__ void ffn_fixup(const Frame& F, int l) {
    const int gt = F.vcu * NTHR + F.tid, NT = F.G * NTHR;
    const float* UH = (const float*)(F.ws + WS_HALO); const float* UF = UH + (size_t)128 * 2 * 5632; bf16* ACT = (bf16*)(F.ws + WS_P);
    const float* cw = inp(F, 29) + (size_t)l * 3 * 5632; const float* cb = inp(F, 30) + l * 5632;
    for (int job = gt; job < 128 * 2816; job += NT) { const int pm = job / 2816, j = job - pm * 2816;
        float o[2];
#pragma unroll
        for (int gv = 0; gv < 2; ++gv) { const int col = gv * 2816 + j;
            const float u0 = *(const GAS float*)(UF + ((size_t)pm * 2) * 5632 + col), u1 = *(const GAS float*)(UF + ((size_t)pm * 2 + 1) * 5632 + col);
            float h0 = 0.f, h1 = 0.f; if (pm & 15) { h0 = *(const GAS float*)(UH + ((size_t)(pm - 1) * 2) * 5632 + col); h1 = *(const GAS float*)(UH + ((size_t)(pm - 1) * 2 + 1) * 5632 + col); }
            const float w0 = cw[col], w1 = cw[5632 + col], w2 = cw[2 * 5632 + col], bb = cb[col];
            const float r0 = bb + w0 * h0 + w1 * h1 + w2 * u0, r1 = bb + w0 * h1 + w1 * u0 + w2 * u1;
            if (gv == 0) { o[0] = pg8::gelu_tanh(r0); o[1] = pg8::gelu_tanh(r1); } else { o[0] *= r0; o[1] *= r1; } }
        *(GAS bf16*)(ACT + (size_t)(pm * 256) * DFF + j) = (bf16)f2bf(o[0]); *(GAS bf16*)(ACT + (size_t)(pm * 256 + 1) * DFF + j) = (bf16)f2bf(o[1]); }
}
__device__ __forceinline__ void in_fixup(const Frame& F, int l) {
    const int gt = F.vcu * NTHR + F.tid, NT = F.G * NTHR;
    const float* UH = (const float*)(F.ws + WS_HALO_IN); const float* UF = UH + (size_t)128 * 3 * 2048; bf16* P = (bf16*)(F.ws + WS_P);
    for (int job = gt; job < 128 * 2048; job += NT) { const int pm = job >> 11, col = job & 2047;
        const float* cw; const float* cb; int cst, ch; bool act;
        if (col < 512) { cw = inp(F, 6) + (size_t)l * 4 * 512; cb = inp(F, 7) + l * 512; cst = 512; ch = col; act = true; }
        else if (col < 1024) { cw = inp(F, 14) + (size_t)l * 4 * 512; cb = inp(F, 15) + l * 512; cst = 512; ch = col - 512; act = false; }
        else { cw = inp(F, 21) + (size_t)l * 4 * 1024; cb = inp(F, 22) + l * 1024; cst = 1024; ch = col - 1024; act = true; }
        const float f0 = *(const GAS float*)(UF + ((size_t)pm * 3 + 0) * 2048 + col), f1 = *(const GAS float*)(UF + ((size_t)pm * 3 + 1) * 2048 + col), f2 = *(const GAS float*)(UF + ((size_t)pm * 3 + 2) * 2048 + col);
        float h0 = 0.f, h1 = 0.f, h2 = 0.f;
        if (pm & 15) { h0 = *(const GAS float*)(UH + ((size_t)(pm - 1) * 3 + 0) * 2048 + col); h1 = *(const GAS float*)(UH + ((size_t)(pm - 1) * 3 + 1) * 2048 + col); h2 = *(const GAS float*)(UH + ((size_t)(pm - 1) * 3 + 2) * 2048 + col); }
        const float w0 = *(const GAS float*)(cw + ch), w1 = *(const GAS float*)(cw + cst + ch), w2 = *(const GAS float*)(cw + 2 * cst + ch), w3 = *(const GAS float*)(cw + 3 * cst + ch), bb = *(const GAS float*)(cb + ch);
        float o0 = bb + w0 * h0 + w1 * h1 + w2 * h2 + w3 * f0, o1 = bb + w0 * h1 + w1 * h2 + w2 * f0 + w3 * f1, o2 = bb + w0 * h2 + w1 * f0 + w2 * f1 + w3 * f2;
        if (act) { o0 = pg8::silu_f(o0); o1 = pg8::silu_f(o1); o2 = pg8::silu_f(o2); }
        bf16* dst = P + (size_t)(pm * 256) * NP + col;
        *(GAS bf16*)dst = (bf16)f2bf(o0); *(GAS bf16*)(dst + NP) = (bf16)f2bf(o1); *(GAS bf16*)(dst + 2 * NP) = (bf16)f2bf(o2); }
}

__global__ void __launch_bounds__(NWAVES * 64, 2) hymba_fwd(Args args) {
    extern __shared__ __attribute__((aligned(16))) unsigned char lds[];
    Frame F;
    F.lds = (LAS unsigned char*)lds;
    F.MISC = (volatile LAS unsigned*)(F.lds + MISC_OFF);
    F.tid = threadIdx.x; F.lane = F.tid & 63; F.wave = __builtin_amdgcn_readfirstlane(F.tid >> 6);
    F.G = gridDim.x; { const int bx = blockIdx.x; F.vcu = (F.G % 8 == 0) ? (bx % 8) * (F.G / 8) + bx / 8 : bx; }
    F.ws = args.ws; F.ctl = (gu32*)(args.ws + WS_CTL);
    for (int u = F.tid; u < (LDS_BYTES - LDSCTL_OFF) / 4; u += NWAVES * 64) ((LAS unsigned*)(F.lds + LDSCTL_OFF))[u] = 0u;
    __syncthreads();
    {
        volatile LAS unsigned long long* pt = (volatile LAS unsigned long long*)(F.lds + PTR_OFF);
#pragma unroll
        for (int k = 0; k < 32; ++k) if (F.tid == k) pt[k] = (unsigned long long)args.in[k];
        if (F.tid == 32) pt[32] = (unsigned long long)args.ws;
    }
    __syncthreads();
    XcdBarrier bar; bar.bar = (unsigned*)(F.ctl + CW_BAR); bar.x = 0; bar.st = nullptr;
    if (!MK_PER_PHASE) bar = xcd_barrier_post((unsigned*)(F.ctl + CW_BAR), F.MISC + 8);
    const int lo = MK_PER_PHASE ? args.ph_lo : 0, hi = MK_PER_PHASE ? args.ph_hi : NPHASES;
    const Frame F0 = F;
#define FRESH() do { int t_ = threadIdx.x; asm volatile("" : "+v"(t_)); F = F0; asm volatile("" : "+s"(F.ws)); F.tid = t_; F.lane = t_ & 63; F.wave = __builtin_amdgcn_readfirstlane(t_ >> 6); } while (0)
#ifndef SKIPMASK
#define SKIPMASK 0
#endif
#define IN(k) (lo <= (k) && (k) < hi)
#ifndef TIMESEL
#define TIMESEL -1
#endif
    unsigned long long tacc = 0, tst = 0;
#define TB(g) do { if (TIMESEL == (g)) tst = __builtin_amdgcn_s_memrealtime(); } while (0)
#define TE(g) do { if (TIMESEL == (g)) tacc += __builtin_amdgcn_s_memrealtime() - tst; } while (0)
#define ON(b) (!((SKIPMASK >> (b)) & 1))
#define SEAM(k) do { if (!MK_PER_PHASE && IN(k) && IN((k) + 1)) { XcdBarrier b_ = bar; asm volatile("" : "+s"(b_.bar), "+s"(b_.x)); xcd_barrier(b_); } } while (0)

    if (IN(0)) { TB(0); FRESH(); if (ON(0)) p0_prologue(F); SEAM(0); TE(0); }

#pragma unroll 1
    for (int l = 0; l < DEPTH; ++l) {
        const int pb = 1 + PH_PER_LAYER * l;
        if (IN(pb + 0)) { TB(1); FRESH();
            pg8::Gemm g{(const bf16*)(F.ws + WS_XN), wlayer(F, l) + W_IN, TOK, NP, DM, DM}; pg8::StaticOrder S; S.init(TOK, NP, F.G, (int)blockIdx.x);
            pg8::EpiIn E{(bf16*)(F.ws + WS_P), F.lds + PTR_OFF, l, WS_HALO_IN, (LAS float*)(F.lds + EPI_OFF)};
            if (ON(1)) pg8::gemm_phase<pg8::EpiIn, pg8::StaticOrder, true, PG8_SP2>(F.lds + RING_OFF, g, S, E);
            FRESH(); if (ON(2)) small_cols(F, l);
            SEAM(pb + 0); TE(1);
        }
        if (IN(pb + 1)) { TB(5); FRESH(); in_fixup(F, l); SEAM(pb + 1); TE(5); }
        if (IN(pb + 2)) { TB(2);
#pragma unroll 1
            for (int it = F.vcu; it < 2048; it += F.G) { FRESH(); if (ON(3)) mlstm_local(F, l, it); }
#pragma unroll 1
            for (int it = F.vcu; it < 1024; it += F.G) { FRESH(); if (ON(4)) ssd_local(F, l, it); }
#pragma unroll 1
            for (int it = F.vcu; it < 1024; it += F.G) { FRESH(); if (ON(5)) rglru_item<false>(F, l, it); }
            SEAM(pb + 2); TE(2);
        }
        if (IN(pb + 3)) { TB(3); FRESH(); if (ON(6)) scans(F); SEAM(pb + 3); TE(3); }
        if (IN(pb + 4)) { TB(4);
#pragma unroll 1
            for (int it = F.vcu; it < 2048; it += F.G) { FRESH(); if (ON(7)) mlstm_out(F, l, it); }
#pragma unroll 1
            for (int it = F.vcu; it < 512; it += F.G) { FRESH(); if (ON(8)) ssd_out(F, l, it); }
#pragma unroll 1
            for (int it = F.vcu; it < 1024; it += F.G) { FRESH(); if (ON(9)) rglru_item<true>(F, l, it); }
            SEAM(pb + 4); TE(4);
        }
        if (IN(pb + 5)) { TB(1); FRESH();
            pg8::Gemm g{(const bf16*)(F.ws + WS_P) + PC_OM, wlayer(F, l) + W_OUT, TOK, DM, KMIX, NP}; pg8::StaticOrder S; S.init(TOK, DM, F.G, (int)blockIdx.x);
            pg8::EpiF32 E{(float*)(F.ws + WS_Y), DM};
            if (ON(10)) pg8::gemm_phase<pg8::EpiF32, pg8::StaticOrder, PG8_ALIGN, PG8_SP2>(F.lds + RING_OFF, g, S, E);
            SEAM(pb + 5); TE(1);
        }
        if (IN(pb + 6)) { TB(5); FRESH(); if (ON(11)) rms_update(F, l == 0 ? inp(F, 0) : args.out, args.out, inp(F, 2) + l * DM, true); SEAM(pb + 6); TE(5); }
        if (IN(pb + 7)) { TB(1); FRESH();
            pg8::Gemm g{(const bf16*)(F.ws + WS_XN), wlayer(F, l) + W_UP, TOK, NUP, DM, DM}; pg8::StaticOrder S; S.init(TOK, NUP, F.G, (int)blockIdx.x);
            pg8::EpiConv E{(bf16*)(F.ws + WS_P), F.lds + PTR_OFF, l, WS_HALO, (LAS float*)(F.lds + EPI_OFF)};
            if (ON(12)) pg8::gemm_phase<pg8::EpiConv, pg8::StaticOrder, true, PG8_SP2>(F.lds + RING_OFF, g, S, E);
            SEAM(pb + 7); TE(1);
        }
        if (IN(pb + 8)) { TB(5); FRESH(); if (ON(13)) ffn_fixup(F, l); SEAM(pb + 8); TE(5); }
        if (IN(pb + 9)) { TB(1); FRESH();
            pg8::Gemm g{(const bf16*)(F.ws + WS_P), wlayer(F, l) + W_DN, TOK, DM, DFF, DFF}; pg8::StaticOrder S; S.init(TOK, DM, F.G, (int)blockIdx.x);
            pg8::EpiF32 E{(float*)(F.ws + WS_Y), DM};
            if (ON(14)) pg8::gemm_phase<pg8::EpiF32, pg8::StaticOrder, PG8_ALIGN, PG8_SP2>(F.lds + RING_OFF, g, S, E);
            SEAM(pb + 9); TE(1);
        }
        if (IN(pb + 10)) { TB(5); FRESH(); if (ON(15)) rms_update(F, args.out, args.out, inp(F, 4) + l * DM, l + 1 < DEPTH); SEAM(pb + 10); TE(5); }
    }
    if (TIMESEL >= 0) { const unsigned long long t0 = __builtin_amdgcn_s_memrealtime(); while (__builtin_amdgcn_s_memrealtime() - t0 < 2 * tacc) __builtin_amdgcn_s_sleep(8); }
#undef IN
#undef SEAM
}

extern "C" void kernel_launch(void* const* d_in, const int* in_sizes, int n_in, void* d_out, int out_size, void* d_ws, size_t ws_size, hipStream_t stream) {
    static int grid = 0;
    if (grid == 0) {
        if (n_in != 32 || in_sizes[0] != TOK * DM || out_size != TOK * DM || ws_size < WS_END) { fprintf(stderr, "kernel_launch: unexpected shapes: n_in %d in0 %d out %d ws %zu (need %zu)\n", n_in, n_in > 0 ? in_sizes[0] : -1, out_size, ws_size, (size_t)WS_END); grid = -1; return; }
        int dev = 0, cus = 0, per_cu = 0;
        if (hipGetDevice(&dev) != hipSuccess || hipDeviceGetAttribute(&cus, hipDeviceAttributeMultiprocessorCount, dev) != hipSuccess) { grid = -1; return; }
        if (hipFuncSetAttribute((const void*)hymba_fwd, hipFuncAttributeMaxDynamicSharedMemorySize, LDS_BYTES) != hipSuccess) { fprintf(stderr, "kernel_launch: hipFuncSetAttribute failed\n"); grid = -1; return; }
        if (hipOccupancyMaxActiveBlocksPerMultiprocessor(&per_cu, (const void*)hymba_fwd, NWAVES * 64, LDS_BYTES) != hipSuccess || per_cu < 1) fprintf(stderr, "kernel_launch: occupancy query says %d\n", per_cu);
        (void)hipGetLastError();
        grid = cus;
        if (grid != 256) fprintf(stderr, "kernel_launch: %d CUs (built for 256)\n", grid);
    }
    if (grid < 0) return;
    if (hipMemsetAsync((char*)d_ws + WS_CTL, 0, CTL_ZERO_BYTES, stream) != hipSuccess) { fprintf(stderr, "kernel_launch: memset failed\n"); return; }
    Args a{};
    for (int i = 0; i < 32; ++i) a.in[i] = (const float*)d_in[i];
    a.out = (float*)d_out; a.ws = (unsigned char*)d_ws;
#if MK_PER_PHASE
    for (int p = 0; p < NPHASES; ++p) { a.ph_lo = p; a.ph_hi = p + 1; hipLaunchKernelGGL(hymba_fwd, dim3(grid), dim3(NWAVES * 64), LDS_BYTES, stream, a); }
#else
    a.ph_lo = 0; a.ph_hi = NPHASES;
    hipLaunchKernelGGL(hymba_fwd, dim3(grid), dim3(NWAVES * 64), LDS_BYTES, stream, a);
#endif
    const hipError_t le = hipPeekAtLastError();
    if (le != hipSuccess) fprintf(stderr, "kernel_launch: launch failed: %s\n", hipGetErrorName(le));
}
```

```cpp
#include <hip/hip_runtime.h>
#include <cstdio>
#include <cstdint>
namespace pg8 {
#define PG8_LAS __attribute__((address_space(3)))
typedef unsigned short bf16_t;
typedef short bf16x8 __attribute__((ext_vector_type(8)));
typedef float f32x4 __attribute__((ext_vector_type(4)));
typedef unsigned u32x4 __attribute__((ext_vector_type(4)));
constexpr int BM = 256, BK = 64, HALF = 128, HTB = HALF * BK * 2  , STAGE_BYTES = 8 * HTB, NXCD = 8, WGM = 8;

__host__ __device__ __forceinline__ int lds_byte(int r, int c) { const int st = (r >> 4) * 2 + (c >> 5), rr = r & 15, cc = c & 31, ob = rr * 64 + cc * 2; return st * 1024 + (ob ^ (((ob >> 9) & 1) << 5)); }
__host__ __device__ __forceinline__ void stage_rc(int b, int& R, int& C) { const int st = b / 1024, sb = b % 1024, swz = sb ^ (((sb >> 9) & 1) << 5); R = (st >> 1) * 16 + swz / 64; C = (st & 1) * 32 + (swz % 64) / 2; }
__host__ __device__ __forceinline__ int perm32(int rho) { const int n = rho >> 4, i = rho & 15; return 8 * (i >> 2) + 4 * n + (i & 3); }

struct Unit { int pm, pn; };
struct Gemm { const bf16_t* A; const bf16_t* Bt; int M, N, K, lda; };

struct StaticOrder {
    int nM, nN, nwg, G, c;
    __host__ __device__ void init(int M, int N, int G_, int c_) { nM = M / BM; nN = N / BM; nwg = nM * nN; G = G_; c = c_; }
    __host__ __device__ bool next(int i, Unit& u) const {
        const long L = (long)i * G + c; if (L >= nwg) return false;
        int wgid = (int)L; { const int q = nwg / NXCD, r = nwg % NXCD, xcd = wgid % NXCD, off = wgid / NXCD; wgid = (xcd < r ? xcd * (q + 1) : r * (q + 1) + (xcd - r) * q) + off; }
        const int nig = WGM * nN, gid = wgid / nig, fm = gid * WGM, gsz = (nM - fm) < WGM ? (nM - fm) : WGM;
        u.pm = fm + ((wgid % nig) % gsz); u.pn = (wgid % nig) / gsz; return true;
    }
    __device__ __forceinline__ void a_ready(const Unit&) const {}
    __device__ __forceinline__ void done(const Unit&) const {}
};

__device__ __forceinline__ unsigned cvt_pk_bf16(float lo, float hi) { unsigned r; asm volatile("v_cvt_pk_bf16_f32 %0, %1, %2" : "=v"(r) : "v"(lo), "v"(hi)); return r; }
typedef float f32x2 __attribute__((ext_vector_type(2)));
struct EpiF32 {
    static constexpr bool PERM = false, AFTER_DRAIN = false;
    float* C; int ldc;
    __device__ __forceinline__ void operator()(const f32x4 (&acc)[2][2][4][2], const Unit& u, int wr, int wc, int fr, int fq) const {
        const int row0 = u.pm * BM + wr * 64 + fr, col0 = u.pn * BM + wc * 32 + 4 * fq;
#pragma unroll
        for (int ai = 0; ai < 2; ++ai)
#pragma unroll
            for (int m = 0; m < 4; ++m) { float* rowp = C + (size_t)(row0 + ai * HALF + m * 16) * ldc + col0;
#pragma unroll
                for (int bj = 0; bj < 2; ++bj)
#pragma unroll
                    for (int n = 0; n < 2; ++n) *(f32x4*)(rowp + bj * HALF + n * 16) = acc[ai][bj][m][n]; }
    }
};
struct EpiBf16P {
    static constexpr bool PERM = true, AFTER_DRAIN = false;
    bf16_t* O; int ldc;
    __device__ __forceinline__ void operator()(const f32x4 (&acc)[2][2][4][2], const Unit& u, int wr, int wc, int fr, int fq) const {
        const int row0 = u.pm * BM + wr * 64 + fr, col0 = u.pn * BM + wc * 32 + 8 * fq;
#pragma unroll
        for (int ai = 0; ai < 2; ++ai)
#pragma unroll
            for (int m = 0; m < 4; ++m) { bf16_t* rowp = O + (size_t)(row0 + ai * HALF + m * 16) * ldc + col0;
#pragma unroll
                for (int bj = 0; bj < 2; ++bj) { const f32x4 v0 = acc[ai][bj][m][0], v1 = acc[ai][bj][m][1];
                    u32x4 w; w.x = cvt_pk_bf16(v0[0], v0[1]); w.y = cvt_pk_bf16(v0[2], v0[3]); w.z = cvt_pk_bf16(v1[0], v1[1]); w.w = cvt_pk_bf16(v1[2], v1[3]);
                    *(u32x4*)(rowp + bj * HALF) = w; } }
    }
};
__device__ __forceinline__ const float* tabf(const PG8_LAS unsigned char* tab, int k) {
    const volatile PG8_LAS unsigned* t = (const volatile PG8_LAS unsigned*)tab + 2 * k;
    const unsigned lo = __builtin_amdgcn_readfirstlane(t[0]), hi = __builtin_amdgcn_readfirstlane(t[1]);
    return (const float*)(((unsigned long long)hi << 32) | lo);
}
__device__ __forceinline__ float dpp_shr1(float old, float src) { return __builtin_bit_cast(float, __builtin_amdgcn_update_dpp(__builtin_bit_cast(int, old), __builtin_bit_cast(int, src), 0x111, 0xf, 0xf, false)); }
__device__ __forceinline__ float dpp_shr2(float old, float src) { return __builtin_bit_cast(float, __builtin_amdgcn_update_dpp(__builtin_bit_cast(int, old), __builtin_bit_cast(int, src), 0x112, 0xf, 0xf, false)); }
__device__ __forceinline__ float dpp_ror1(float src) { return __builtin_bit_cast(float, __builtin_amdgcn_update_dpp(0, __builtin_bit_cast(int, src), 0x121, 0xf, 0xf, false)); }
__device__ __forceinline__ float dpp_ror2(float src) { return __builtin_bit_cast(float, __builtin_amdgcn_update_dpp(0, __builtin_bit_cast(int, src), 0x122, 0xf, 0xf, false)); }
__device__ __forceinline__ float gelu_tanh(float x) {
    const float t = x * (1.0f + 0.044715f * x * x) * (-2.0f * 0.7978845608028654f * 1.4426950408889634f);
    return x * __builtin_amdgcn_rcpf(1.0f + __builtin_amdgcn_exp2f(t));
}
typedef unsigned u32x2 __attribute__((ext_vector_type(2)));
struct EpiConv {
    static constexpr bool PERM = true, AFTER_DRAIN = false;
    bf16_t* act; const PG8_LAS unsigned char* tab; int l; size_t halo_off; PG8_LAS float* scr;
    __device__ __forceinline__ void operator()(const f32x4 (&acc)[2][2][4][2], const Unit& u, int wr, int wc, int fr, int fq) const {
        const float* cw = tabf(tab, 29) + (size_t)l * 3 * 5632; const float* cb = tabf(tab, 30) + l * 5632;
        float* uhalo = (float*)((unsigned char*)tabf(tab, 32) + halo_off); float* ufix = uhalo + (size_t)128 * 2 * 5632;
        const int jg = u.pn * 128 + wc * 32 + 8 * fq;
        if (fr >= 14) {
#pragma unroll
            for (int ai = 0; ai < 2; ++ai) { const int grp = 2 * ai + wr; PG8_LAS float* base = scr + ((wc * 4 + grp) * 2 + (fr - 14)) * 64 + fq * 16;
#pragma unroll
                for (int bj = 0; bj < 2; ++bj)
#pragma unroll
                    for (int n = 0; n < 2; ++n) *(PG8_LAS f32x4*)(base + bj * 8 + n * 4) = acc[ai][bj][3][n]; }
            if (wr == 1) { float* hp = uhalo + ((size_t)u.pm * 2 + (fr - 14)) * 5632 + jg;
#pragma unroll
                for (int bj = 0; bj < 2; ++bj)
#pragma unroll
                    for (int n = 0; n < 2; ++n) *(f32x4*)(hp + bj * 2816 + 4 * n) = acc[1][bj][3][n]; }
        }
        if (wr == 0 && fr < 2) { float* fp = ufix + ((size_t)u.pm * 2 + fr) * 5632 + jg;
#pragma unroll
            for (int bj = 0; bj < 2; ++bj)
#pragma unroll
                for (int n = 0; n < 2; ++n) *(f32x4*)(fp + bj * 2816 + 4 * n) = acc[0][bj][0][n]; }
        asm volatile("s_waitcnt lgkmcnt(0)" ::: "memory"); __builtin_amdgcn_s_barrier(); asm volatile("" ::: "memory");
#pragma unroll
        for (int n = 0; n < 2; ++n) {
            f32x4 wg[3], wv[3];
#pragma unroll
            for (int k = 0; k < 3; ++k) { wg[k] = *(const f32x4*)(cw + k * 5632 + jg + 4 * n); wv[k] = *(const f32x4*)(cw + k * 5632 + 2816 + jg + 4 * n); }
            const f32x4 bg = *(const f32x4*)(cb + jg + 4 * n), bv = *(const f32x4*)(cb + 2816 + jg + 4 * n);
#pragma unroll
            for (int ai = 0; ai < 2; ++ai) {
                const int grp = 2 * ai + wr;
                f32x4 h0[2], h1[2];
                { const PG8_LAS float* base = scr + ((wc * 4 + (grp > 0 ? grp - 1 : 0)) * 2) * 64 + fq * 16 + n * 4;
#pragma unroll
                  for (int bj = 0; bj < 2; ++bj) { h0[bj] = *(const PG8_LAS f32x4*)(base + bj * 8); h1[bj] = *(const PG8_LAS f32x4*)(base + 64 + bj * 8); } }
#pragma unroll
                for (int m = 0; m < 4; ++m) {
                    f32x4 p1[2], p2[2], o;
#pragma unroll
                    for (int bj = 0; bj < 2; ++bj)
#pragma unroll
                        for (int j = 0; j < 4; ++j) { const float cur = acc[ai][bj][m][n][j]; float x1, x2;
                            if (m > 0) { const float pv = acc[ai][bj][m > 0 ? m - 1 : 0][n][j]; x1 = dpp_ror1(pv); x2 = dpp_ror2(pv); }
                            else { x1 = h1[bj][j]; x2 = (fr == 0) ? h0[bj][j] : h1[bj][j]; }
                            p1[bj][j] = dpp_shr1(x1, cur); p2[bj][j] = dpp_shr2(x2, cur); }
#pragma unroll
                    for (int j = 0; j < 4; ++j) {
                        const float g = bg[j] + wg[0][j] * p2[0][j] + wg[1][j] * p1[0][j] + wg[2][j] * acc[ai][0][m][n][j];
                        const float v = bv[j] + wv[0][j] * p2[1][j] + wv[1][j] * p1[1][j] + wv[2][j] * acc[ai][1][m][n][j];
                        o[j] = gelu_tanh(g) * v; }
                    const int rit = ai * HALF + wr * 64 + m * 16 + fr;
                    if (!(grp == 0 && m == 0 && fr < 2)) {
                        u32x2 w; w.x = cvt_pk_bf16(o[0], o[1]); w.y = cvt_pk_bf16(o[2], o[3]);
                        *(u32x2*)(act + (size_t)(u.pm * BM + rit) * 2816 + jg + 4 * n) = w; }
                }
            }
        }
    }
};

__device__ __forceinline__ float dpp_shr3(float old, float src) { return __builtin_bit_cast(float, __builtin_amdgcn_update_dpp(__builtin_bit_cast(int, old), __builtin_bit_cast(int, src), 0x113, 0xf, 0xf, false)); }
__device__ __forceinline__ float dpp_ror3(float src) { return __builtin_bit_cast(float, __builtin_amdgcn_update_dpp(0, __builtin_bit_cast(int, src), 0x123, 0xf, 0xf, false)); }
__device__ __forceinline__ float silu_f(float x) { return x * __builtin_amdgcn_rcpf(1.0f + __builtin_amdgcn_exp2f(x * -1.4426950408889634f)); }
struct EpiIn {
    static constexpr bool PERM = true, AFTER_DRAIN = false;
    bf16_t* O; const PG8_LAS unsigned char* tab; int l; size_t halo_off; PG8_LAS float* scr;
    __device__ __forceinline__ void operator()(const f32x4 (&acc)[2][2][4][2], const Unit& u, int wr, int wc, int fr, int fq) const {
        const int row0 = u.pm * BM + wr * 64 + fr, cl = wc * 32 + 8 * fq;
        if (u.pn >= 8) {
            const int col0 = u.pn * BM + cl;
#pragma unroll
            for (int ai = 0; ai < 2; ++ai)
#pragma unroll
                for (int m = 0; m < 4; ++m) { bf16_t* rowp = O + (size_t)(row0 + ai * HALF + m * 16) * 4096 + col0;
#pragma unroll
                    for (int bj = 0; bj < 2; ++bj) { const f32x4 v0 = acc[ai][bj][m][0], v1 = acc[ai][bj][m][1];
                        u32x4 w; w.x = cvt_pk_bf16(v0[0], v0[1]); w.y = cvt_pk_bf16(v0[2], v0[3]); w.z = cvt_pk_bf16(v1[0], v1[1]); w.w = cvt_pk_bf16(v1[2], v1[3]);
                        *(u32x4*)(rowp + bj * HALF) = w; } }
            return;
        }
        const bool act = (u.pn < 2) || (u.pn >= 4);
        const float* cw; const float* cb; int cst, ch0;
        if (u.pn < 2) { cw = tabf(tab, 6) + (size_t)l * 2048; cb = tabf(tab, 7) + l * 512; cst = 512; ch0 = u.pn * 256; } else if (u.pn < 4) { cw = tabf(tab, 14) + (size_t)l * 2048; cb = tabf(tab, 15) + l * 512; cst = 512; ch0 = (u.pn - 2) * 256; }
        else { cw = tabf(tab, 21) + (size_t)l * 4096; cb = tabf(tab, 22) + l * 1024; cst = 1024; ch0 = (u.pn - 4) * 256; }
        float* uhalo = (float*)((unsigned char*)tabf(tab, 32) + halo_off); float* ufix = uhalo + (size_t)128 * 3 * 2048;
        const int ccol = u.pn * BM + cl;
        if (fr >= 13) {
#pragma unroll
            for (int ai = 0; ai < 2; ++ai) { const int grp = 2 * ai + wr; PG8_LAS float* base = scr + ((wc * 4 + grp) * 3 + (fr - 13)) * 64 + fq * 16;
#pragma unroll
                for (int bj = 0; bj < 2; ++bj)
#pragma unroll
                    for (int n = 0; n < 2; ++n) *(PG8_LAS f32x4*)(base + bj * 8 + n * 4) = acc[ai][bj][3][n]; }
            if (wr == 1) { float* hp = uhalo + ((size_t)u.pm * 3 + (fr - 13)) * 2048 + ccol;
#pragma unroll
                for (int bj = 0; bj < 2; ++bj)
#pragma unroll
                    for (int n = 0; n < 2; ++n) *(f32x4*)(hp + bj * HALF + 4 * n) = acc[1][bj][3][n]; }
        }
        if (wr == 0 && fr < 3) { float* fp = ufix + ((size_t)u.pm * 3 + fr) * 2048 + ccol;
#pragma unroll
            for (int bj = 0; bj < 2; ++bj)
#pragma unroll
                for (int n = 0; n < 2; ++n) *(f32x4*)(fp + bj * HALF + 4 * n) = acc[0][bj][0][n]; }
        asm volatile("s_waitcnt lgkmcnt(0)" ::: "memory"); __builtin_amdgcn_s_barrier(); asm volatile("" ::: "memory");
#pragma unroll
        for (int bj = 0; bj < 2; ++bj) {
#pragma unroll
            for (int n = 0; n < 2; ++n) {
                const int ch = ch0 + bj * HALF + cl + 4 * n;
                f32x4 w[4];
#pragma unroll
                for (int k = 0; k < 4; ++k) w[k] = *(const f32x4*)(cw + k * cst + ch);
                const f32x4 bb = *(const f32x4*)(cb + ch);
#pragma unroll
                for (int ai = 0; ai < 2; ++ai) {
                    const int grp = 2 * ai + wr;
                    const PG8_LAS float* base = scr + ((wc * 4 + (grp > 0 ? grp - 1 : 0)) * 3) * 64 + fq * 16 + bj * 8 + n * 4;
                    const f32x4 h0 = *(const PG8_LAS f32x4*)(base), h1 = *(const PG8_LAS f32x4*)(base + 64), h2 = *(const PG8_LAS f32x4*)(base + 128);
#pragma unroll
                    for (int m = 0; m < 4; ++m) {
                        f32x4 o;
#pragma unroll
                        for (int j = 0; j < 4; ++j) { const float cur = acc[ai][bj][m][n][j]; float x1, x2, x3;
                            if (m > 0) { const float pv = acc[ai][bj][m > 0 ? m - 1 : 0][n][j]; x1 = dpp_ror1(pv); x2 = dpp_ror2(pv); x3 = dpp_ror3(pv); }
                            else { x1 = h2[j]; x2 = (fr == 0) ? h1[j] : h2[j]; x3 = (fr == 0) ? h0[j] : (fr == 1 ? h1[j] : h2[j]); }
                            const float p1 = dpp_shr1(x1, cur), p2 = dpp_shr2(x2, cur), p3 = dpp_shr3(x3, cur);
                            const float v = bb[j] + w[0][j] * p3 + w[1][j] * p2 + w[2][j] * p1 + w[3][j] * cur;
                            o[j] = act ? silu_f(v) : v; }
                        const int rit = ai * HALF + wr * 64 + m * 16 + fr;
                        if (!(grp == 0 && m == 0 && fr < 3)) { u32x2 wv; wv.x = cvt_pk_bf16(o[0], o[1]); wv.y = cvt_pk_bf16(o[2], o[3]);
                            *(u32x2*)(O + (size_t)(u.pm * BM + rit) * 4096 + ccol + bj * HALF + 4 * n) = wv; }
                    }
                }
            }
        }
    }
};
template <class Epi, class Sched, bool ALIGN_EPI = false, bool SP2 = false>
__device__ __forceinline__ void gemm_phase(PG8_LAS unsigned char* lds, const Gemm g, const Sched& S, const Epi& E) {
    int tid_ = threadIdx.x; asm volatile("" : "+v"(tid_));
    const int tid = tid_, wid = __builtin_amdgcn_readfirstlane(tid >> 6), lane = tid & 63, wr = wid >> 2, wc = wid & 3, fr = lane & 15, fq = lane >> 4;
    const int K = g.K, nt = K / BK;
    unsigned voffA[2], voffB[2];
#pragma unroll
    for (int i = 0; i < 2; ++i) { int R, C; stage_rc(tid * 16 + i * 8192, R, C); const int Rb = Epi::PERM ? ((R & ~31) + perm32(R & 31)) : R;
        voffA[i] = (unsigned)(R * g.lda + C) * 2u; voffB[i] = (unsigned)(Rb * K + C) * 2u; }
    const size_t kstep = (size_t)(BK * 2);
    const size_t hstep = (size_t)HALF * K * 2;
    const size_t tstep = 2 * hstep; const size_t hstepA = (size_t)HALF * g.lda * 2, tstepA = 2 * hstepA;
    const unsigned ldsw = (unsigned)wid * 1024u;
    const int aoff = lds_byte(wr * 64 + fr, fq * 8), boff = lds_byte(wc * 32 + fr, fq * 8);
#define PG8_SA(b, h) (((b) * 2 + (h)) * HTB)
#define PG8_SB(b, h) ((4 + (b) * 2 + (h)) * HTB)
#define PG8_STAGE(bufoff, gbase, voff) do { _Pragma("unroll") for (int _i = 0; _i < 2; ++_i) \
        __builtin_amdgcn_global_load_lds((const unsigned*)((const char*)(gbase) + (voff)[_i]), (PG8_LAS unsigned*)(lds + (bufoff) + ldsw + _i * 8192), 16, 0, 0); } while (0)
#define PG8_LDA(dst, b, h) do { _Pragma("unroll") for (int m = 0; m < 4; ++m) _Pragma("unroll") for (int k = 0; k < 2; ++k) dst[m][k] = *(const PG8_LAS bf16x8*)(lds + PG8_SA(b, h) + aoff + m * 2048 + k * 1024); } while (0)
#define PG8_LDB(dst, b, h) do { _Pragma("unroll") for (int n = 0; n < 2; ++n) _Pragma("unroll") for (int k = 0; k < 2; ++k) dst[n][k] = *(const PG8_LAS bf16x8*)(lds + PG8_SB(b, h) + boff + n * 2048 + k * 1024); } while (0)
#define PG8_MMA(ai, bj, At, Bt) do { __builtin_amdgcn_s_setprio(1); _Pragma("unroll") for (int m = 0; m < 4; ++m) _Pragma("unroll") for (int n = 0; n < 2; ++n) _Pragma("unroll") for (int k = 0; k < 2; ++k) \
        acc[ai][bj][m][n] = __builtin_amdgcn_mfma_f32_16x16x32_bf16(Bt[n][k], At[m][k], acc[ai][bj][m][n], 0, 0, 0); __builtin_amdgcn_s_setprio(0); } while (0)
#define PG8_WAIT_V(n) asm volatile("s_waitcnt vmcnt(" #n ")" ::: "memory")
#define PG8_WAIT_L(n) asm volatile("s_waitcnt lgkmcnt(" #n ")" ::: "memory")
#define PG8_BAR __builtin_amdgcn_s_barrier()
#define PG8_SCHED __builtin_amdgcn_sched_barrier(0)
    Unit cur, nxt; int ui = 0;
    if (!S.next(0, cur)) return;
    f32x4 acc[2][2][4][2];
#pragma unroll
    for (int a = 0; a < 2; ++a)
#pragma unroll
        for (int b = 0; b < 2; ++b)
#pragma unroll
            for (int m = 0; m < 4; ++m)
#pragma unroll
                for (int n = 0; n < 2; ++n) acc[a][b][m][n] = (f32x4){0.f, 0.f, 0.f, 0.f};
    bf16x8 At[4][2], B0[2][2], B1[2][2];
    const char* cA = (const char*)g.A + (size_t)cur.pm * tstepA; const char* cB = (const char*)g.Bt + (size_t)cur.pn * tstep;
    S.a_ready(cur);
    if constexpr (SP2) {
        PG8_STAGE(PG8_SB(0, 0), cB, voffB); PG8_STAGE(PG8_SB(0, 1), cB + hstep, voffB); PG8_STAGE(PG8_SA(0, 0), cA, voffA); PG8_STAGE(PG8_SA(0, 1), cA + hstepA, voffA);
        if (wr == 1) PG8_BAR;
        PG8_WAIT_V(2); PG8_BAR;
        PG8_STAGE(PG8_SB(1, 0), cB + kstep, voffB); PG8_STAGE(PG8_SA(1, 0), cA + kstep, voffA); PG8_STAGE(PG8_SB(1, 1), cB + hstep + kstep, voffB);
        PG8_WAIT_V(6); PG8_BAR;
    } else {
        PG8_STAGE(PG8_SB(0, 0), cB, voffB); PG8_STAGE(PG8_SA(0, 0), cA, voffA); PG8_STAGE(PG8_SB(0, 1), cB + hstep, voffB); PG8_STAGE(PG8_SA(0, 1), cA + hstepA, voffA);
        if (wr == 1) PG8_BAR;
        PG8_WAIT_V(4); PG8_BAR;
        PG8_STAGE(PG8_SB(1, 0), cB + kstep, voffB); PG8_STAGE(PG8_SA(1, 0), cA + kstep, voffA); PG8_STAGE(PG8_SB(1, 1), cB + hstep + kstep, voffB);
        PG8_WAIT_V(6); PG8_BAR;
    }
    for (;;) {
        const bool has_next = S.next(ui + 1, nxt);
        const char* nA = has_next ? (const char*)g.A + (size_t)nxt.pm * tstepA : cA; const char* nB = has_next ? (const char*)g.Bt + (size_t)nxt.pn * tstep : cB;
        for (int t = 0; t < nt; t += 2) {
            const bool last = (t == nt - 2);
            const char* a1 = cA + (size_t)(t + 1) * kstep;
            const char* a2 = last ? nA : cA + (size_t)(t + 2) * kstep; const char* b2 = last ? nB : cB + (size_t)(t + 2) * kstep;
            const char* a3 = a2 + kstep; const char* b3 = b2 + kstep;
            if (last && has_next) S.a_ready(nxt);
            if constexpr (SP2) {
            PG8_LDB(B0, 0, 0); PG8_LDB(B1, 0, 1); PG8_SCHED; PG8_LDA(At, 0, 0); PG8_STAGE(PG8_SA(1, 1), a1 + hstepA, voffA);
            PG8_WAIT_V(8); PG8_WAIT_L(0); PG8_BAR; PG8_MMA(0, 0, At, B0); PG8_MMA(0, 1, At, B1); PG8_BAR; PG8_SCHED;
            PG8_LDA(At, 0, 1); PG8_STAGE(PG8_SB(0, 0), b2, voffB); PG8_STAGE(PG8_SB(0, 1), b2 + hstep, voffB); PG8_STAGE(PG8_SA(0, 0), a2, voffA);
            PG8_WAIT_V(8); PG8_WAIT_L(0); PG8_BAR; PG8_MMA(1, 0, At, B0); PG8_MMA(1, 1, At, B1); PG8_BAR; PG8_SCHED;
            PG8_LDB(B0, 1, 0); PG8_LDB(B1, 1, 1); PG8_SCHED; PG8_LDA(At, 1, 0); PG8_STAGE(PG8_SA(0, 1), a2 + hstepA, voffA);
            PG8_WAIT_V(8); PG8_WAIT_L(0); PG8_BAR; PG8_MMA(0, 0, At, B0); PG8_MMA(0, 1, At, B1); PG8_BAR; PG8_SCHED;
            PG8_LDA(At, 1, 1); PG8_STAGE(PG8_SB(1, 0), b3, voffB); PG8_STAGE(PG8_SB(1, 1), b3 + hstep, voffB); PG8_STAGE(PG8_SA(1, 0), a3, voffA);
            PG8_WAIT_V(8); PG8_WAIT_L(0); PG8_BAR; PG8_MMA(1, 0, At, B0); PG8_MMA(1, 1, At, B1); PG8_BAR; PG8_SCHED;
            } else {
            PG8_LDB(B0, 0, 0); PG8_SCHED; PG8_LDA(At, 0, 0); PG8_STAGE(PG8_SA(1, 1), a1 + hstepA, voffA);
            PG8_WAIT_L(8); PG8_BAR; PG8_WAIT_L(0); PG8_MMA(0, 0, At, B0); PG8_BAR; PG8_SCHED;
            PG8_LDB(B1, 0, 1); PG8_STAGE(PG8_SB(0, 0), b2, voffB);
            PG8_BAR; PG8_WAIT_L(0); PG8_MMA(0, 1, At, B1); PG8_BAR;
            PG8_LDA(At, 0, 1); PG8_STAGE(PG8_SA(0, 0), a2, voffA);
            PG8_BAR; PG8_WAIT_L(0); PG8_MMA(1, 0, At, B0); PG8_BAR; PG8_SCHED;
            PG8_STAGE(PG8_SB(0, 1), b2 + hstep, voffB);
            PG8_WAIT_V(6); PG8_BAR; PG8_MMA(1, 1, At, B1); PG8_BAR;
            PG8_LDB(B0, 1, 0); PG8_SCHED; PG8_LDA(At, 1, 0); PG8_STAGE(PG8_SA(0, 1), a2 + hstepA, voffA);
            PG8_WAIT_L(8); PG8_BAR; PG8_WAIT_L(0); PG8_MMA(0, 0, At, B0); PG8_BAR; PG8_SCHED;
            PG8_LDB(B1, 1, 1); PG8_STAGE(PG8_SB(1, 0), b3, voffB);
            PG8_BAR; PG8_WAIT_L(0); PG8_MMA(0, 1, At, B1); PG8_BAR;
            PG8_LDA(At, 1, 1); PG8_STAGE(PG8_SA(1, 0), a3, voffA);
            PG8_BAR; PG8_WAIT_L(0); PG8_MMA(1, 0, At, B0); PG8_BAR; PG8_SCHED;
            PG8_STAGE(PG8_SB(1, 1), b3 + hstep, voffB);
            PG8_WAIT_V(6); PG8_BAR; PG8_MMA(1, 1, At, B1); PG8_BAR;
            }
        }
        if constexpr (ALIGN_EPI) { if (wr == 0) PG8_BAR; }
        if constexpr (!Epi::AFTER_DRAIN) { E(acc, cur, wr, wc, fr, fq); S.done(cur); }
        if (!has_next) break;
#pragma unroll
        for (int a = 0; a < 2; ++a)
#pragma unroll
            for (int b = 0; b < 2; ++b)
#pragma unroll
                for (int m = 0; m < 4; ++m)
#pragma unroll
                    for (int n = 0; n < 2; ++n) acc[a][b][m][n] = (f32x4){0.f, 0.f, 0.f, 0.f};
        cur = nxt; cA = nA; cB = nB; ++ui;
        if constexpr (ALIGN_EPI) { if (wr == 1) PG8_BAR; }
    }
    PG8_WAIT_V(0);
    if constexpr (!ALIGN_EPI) { if (wr == 0) PG8_BAR; }
    PG8_BAR;
    if constexpr (Epi::AFTER_DRAIN) { E.fused(acc, cur, wr, wc, fr, fq, lds, wid, lane); S.done(cur); }
#undef PG8_SA
#undef PG8_SB
#undef PG8_STAGE
#undef PG8_LDA
#undef PG8_LDB
#undef PG8_MMA
#undef PG8_WAIT_V
#undef PG8_WAIT_L
#undef PG8_BAR
#undef PG8_SCHED
}
}


#ifndef PG8_SP2
#define PG8_SP2 true
#endif
#ifndef PG8_ALIGN
#define PG8_ALIGN true
#endif
constexpr int NWAVES = 8, NTHR = 512;
#ifndef MK_PER_PHASE
#define MK_PER_PHASE 0
#endif
constexpr int BATCH = 8, SEQ = 4096, TOK = BATCH * SEQ, DM = 1024, NP = 4096, DFF = 2816, NUP = 5632, KMIX = 1536, NCHK = 64, DEPTH = 2;
constexpr int PC_XC = 0, PC_XR = 512, PC_XBC = 1024, PC_OM = 2048, PC_YR = 2560, PC_ZS = 3072, PC_V = 3584;
constexpr float EPS = 1e-6f;
constexpr int PH_PER_LAYER = 11, NPHASES = 1 + PH_PER_LAYER * DEPTH;
constexpr size_t W_IN = 0, W_OUT = W_IN + (size_t)4112 * 1024, W_UP = W_OUT + (size_t)1024 * 1536, W_DN = W_UP + (size_t)5632 * 1024, W_Q = W_DN + (size_t)1024 * 2816,
                 W_K = W_Q + 65536, W_V = W_K + 65536, W_A = W_V + 65536, W_X = W_A + 32768, W_LAYER = W_X + 32768;
constexpr size_t MiB = 1u << 20;
constexpr size_t WS_CTL = 0, CTL_ZERO_BYTES = 1 * MiB;
constexpr size_t WS_W = 1 * MiB, WS_XN = 58 * MiB, WS_P = 122 * MiB, WS_PS = 378 * MiB, WS_MC = 380 * MiB, WS_SS = 444 * MiB, WS_Y = WS_MC, WS_END = 508 * MiB;
constexpr size_t WS_MN = WS_XN, WS_MS = WS_XN + 1 * MiB, WS_RG = WS_XN + 2 * MiB, WS_GT = WS_XN + 4 * MiB;
constexpr size_t WS_HALO = WS_MC;
constexpr size_t WS_HALO_IN = WS_SS;
static_assert(WS_W + 2 * W_LAYER * 2 <= WS_XN, "weights fit");
constexpr int CW_TMO = 0, CW_BAR = 4096;
constexpr int RING_OFF = 0, RING_BYTES = 131072, LDSCTL_OFF = RING_BYTES, MISC_OFF = LDSCTL_OFF + 320, PTR_OFF = LDSCTL_OFF + 512, EPI_OFF = LDSCTL_OFF + 1024, LDS_BYTES = 147456;
static_assert(EPI_OFF + 12288 <= LDS_BYTES, "epilogue scratch");

#define GAS __attribute__((address_space(1)))
#define LAS __attribute__((address_space(3)))
typedef unsigned short bf16;
typedef unsigned v4u __attribute__((ext_vector_type(4)));
typedef unsigned v2u __attribute__((ext_vector_type(2)));
typedef float f32x4 __attribute__((ext_vector_type(4)));
typedef short bf16x8 __attribute__((ext_vector_type(8)));
typedef GAS unsigned gu32;
#define RLX_AGENT __ATOMIC_RELAXED, __HIP_MEMORY_SCOPE_AGENT
#define LDS_WAIT() asm volatile("s_waitcnt lgkmcnt(0)" ::: "memory")
#define VM_WAIT() asm volatile("s_waitcnt vmcnt(0)" ::: "memory")
__device__ __forceinline__ unsigned f2bf(float f) { unsigned u = __builtin_bit_cast(unsigned, f); return (u + 0x7fffu + ((u >> 16) & 1u)) >> 16; }
__device__ __forceinline__ unsigned pk2(float lo, float hi) { return f2bf(lo) | (f2bf(hi) << 16); }
__device__ __forceinline__ float bf2f(unsigned b) { return __builtin_bit_cast(float, b << 16); }
__device__ __forceinline__ float lo16(unsigned w) { return __builtin_bit_cast(float, w << 16); }
__device__ __forceinline__ float hi16(unsigned w) { return __builtin_bit_cast(float, w & 0xffff0000u); }
__device__ __forceinline__ float sigmoidf_(float x) { return __builtin_amdgcn_rcpf(1.0f + __expf(-x)); }
__device__ __forceinline__ float siluf_(float x) { return x * sigmoidf_(x); }
__device__ __forceinline__ float softplusf_(float x) { return fmaxf(x, 0.f) + log1pf(__expf(-fabsf(x))); }
#define XB_TMO      128
#define XB_XCNT(j)  (256  + 64 * (j))
#define XB_XSUB(j)  (1280 + 64 * (j))
#define XB_XGEN(j)  (2304 + 64 * (j))
#define XB_TOP      3328
#define XB_TOPGEN   3392
#define XCD_BAR_WORDS 3456
#define XB_SPIN_CAP (1u << 18)

__device__ __forceinline__ unsigned xb_ld(unsigned* p)              { return __hip_atomic_load(p, __ATOMIC_RELAXED, __HIP_MEMORY_SCOPE_AGENT); }
__device__ __forceinline__ unsigned xb_add(unsigned* p, unsigned v) { return __hip_atomic_fetch_add(p, v, __ATOMIC_RELAXED, __HIP_MEMORY_SCOPE_AGENT); }
__device__ __forceinline__ unsigned xb_xcc_id() { return (unsigned)__builtin_amdgcn_s_getreg((3 << 11) | 20) & 0xFu; }
#define XB_SPIN(cond, bar) do { unsigned _sp = 0; while (cond) { __builtin_amdgcn_s_sleep(1); \
    if ((++_sp & 255u) == 0u) { if (xb_ld(&(bar)[XB_TMO])) break; if (_sp > XB_SPIN_CAP) { atomicAdd(&(bar)[XB_TMO], 1u); break; } } } } while (0)

struct XcdBarrier {
    unsigned* bar; unsigned x;
    volatile LAS unsigned* st;
};

__device__ __forceinline__ XcdBarrier xcd_barrier_post(unsigned* bar, volatile LAS unsigned* st) {
    XcdBarrier b; b.bar = bar; b.x = xb_xcc_id(); b.st = st;
    if (threadIdx.x == 0) (void)xb_add(&bar[XB_XCNT(b.x)], 1u);
    return b;
}
__device__ __forceinline__ void xcd_barrier_complete(unsigned* bar, unsigned x, unsigned& nloc, unsigned& nx) {
    const unsigned G = gridDim.x * gridDim.y * gridDim.z;
    unsigned sum, cnt, mine, sp = 0u;
    for (;;) {
        sum = 0u; cnt = 0u; mine = 0u;
#pragma unroll
        for (unsigned j = 0; j < 16; ++j) { const unsigned c = xb_ld(&bar[XB_XCNT(j)]); sum += c; cnt += (c > 0u) ? 1u : 0u; mine = (j == x) ? c : mine; }
        if (sum == G) break;
        __builtin_amdgcn_s_sleep(1);
        if ((++sp & 255u) == 0u) { if (xb_ld(&bar[XB_TMO])) break; if (sp > XB_SPIN_CAP) { atomicAdd(&bar[XB_TMO], 1u); break; } }
    }
    nloc = mine > 0u ? mine : 1u; nx = cnt > 0u ? cnt : 1u;
}

__device__ __forceinline__ void xcd_barrier(const XcdBarrier& b) {
    asm volatile("s_waitcnt vmcnt(0)" ::: "memory");
    __syncthreads();
    if (threadIdx.x == 0) {
        unsigned* bar = b.bar;
        __builtin_amdgcn_s_waitcnt(0);
        unsigned nloc = b.st[0], nx = b.st[1];
        if (nloc == 0u) { xcd_barrier_complete(bar, b.x, nloc, nx); b.st[0] = nloc; b.st[1] = nx; }
        const unsigned old = xb_add(&bar[XB_XSUB(b.x)], 1u);
        const unsigned gen = old / nloc;
        if (old + 1u == (gen + 1u) * nloc) {
            __builtin_amdgcn_fence(__ATOMIC_RELEASE, "agent");
            asm volatile("s_waitcnt vmcnt(0)" ::: "memory");
            const unsigned og = xb_add(&bar[XB_TOP], 1u);
            const unsigned tg = og / nx;
            if (og + 1u == (tg + 1u) * nx) xb_add(&bar[XB_TOPGEN], 1u);
            else XB_SPIN(xb_ld(&bar[XB_TOPGEN]) == tg, bar);
            __builtin_amdgcn_fence(__ATOMIC_ACQUIRE, "agent");
            xb_add(&bar[XB_XGEN(b.x)], 1u);
            asm volatile("s_waitcnt vmcnt(0)" ::: "memory");
        } else {
            XB_SPIN(xb_ld(&bar[XB_XGEN(b.x)]) == gen, bar);
            __builtin_amdgcn_fence(__ATOMIC_ACQUIRE, "agent");
            asm volatile("s_waitcnt vmcnt(0)" ::: "memory");
        }
    }
    __syncthreads();
}

struct Args { const float* in[32]; float* out; unsigned char* ws; int ph_lo, ph_hi; };
struct Frame {
    LAS unsigned char* lds; volatile LAS unsigned* MISC; gu32* ctl;
    int tid, lane, wave, vcu, G;
    unsigned char* ws;
};
__device__ __forceinline__ const float* inp(const Frame& F, int k) {
    const volatile LAS unsigned* t = (const volatile LAS unsigned*)(F.lds + PTR_OFF) + 2 * k;
    const unsigned lo = __builtin_amdgcn_readfirstlane(t[0]), hi = __builtin_amdgcn_readfirstlane(t[1]);
    return (const float*)(((unsigned long long)hi << 32) | lo);
}
__device__ __forceinline__ const bf16* wlayer(const Frame& F, int l) { return (const bf16*)(F.ws + WS_W) + (size_t)l * W_LAYER; }

__device__ __forceinline__ float wave_sum(float v) {
#pragma unroll
    for (int o = 1; o < 64; o <<= 1) v += __shfl_xor(v, o);
    return v;
}
__device__ __forceinline__ float wave_maxf(float v) {
#pragma unroll
    for (int o = 1; o < 64; o <<= 1) v = fmaxf(v, __shfl_xor(v, o));
    return v;
}
__device__ __forceinline__ float wave_incl_sum(float v, int lane) {
#pragma unroll
    for (int o = 1; o < 64; o <<= 1) { const float t = __shfl_up(v, o); if (lane >= o) v += t; }
    return v;
}
__device__ __forceinline__ float wave_incl_max(float v, int lane) {
#pragma unroll
    for (int o = 1; o < 64; o <<= 1) { const float t = __shfl_up(v, o); if (lane >= o) v = fmaxf(v, t); }
    return v;
}
__device__ __forceinline__ void lds_addf(LAS float* p, float v) { (void)__hip_atomic_fetch_add(p, v, __ATOMIC_RELAXED, __HIP_MEMORY_SCOPE_WORKGROUP); }
__device__ __forceinline__ float logsigmoidf_(float x) { return fminf(x, 0.f) - log1pf(__expf(-fabsf(x))); }

#define MFMA16(btf, af, c) __builtin_amdgcn_mfma_f32_16x16x32_bf16(btf, af, c, 0, 0, 0)
__device__ __forceinline__ bf16x8 ldl8(const LAS bf16* p) { return *(const LAS bf16x8*)p; }
__device__ __forceinline__ bf16x8 ldg8(const bf16* p) { return *(const GAS bf16x8*)p; }
__device__ __forceinline__ v2u pack4(f32x4 v) { v2u w; w.x = pk2(v[0], v[1]); w.y = pk2(v[2], v[3]); return w; }
__device__ __forceinline__ v4u pack8(const float (&o)[8]) { v4u w; w.x = pk2(o[0], o[1]); w.y = pk2(o[2], o[3]); w.z = pk2(o[4], o[5]); w.w = pk2(o[6], o[7]); return w; }

template <bool SILU> __device__ __forceinline__ void conv8(const bf16* pr, int pos, const float* w, int wstride, const float* bias, float (&o)[8], v4u& raw) {
    const f32x4 b0 = *(const GAS f32x4*)bias, b1 = *(const GAS f32x4*)(bias + 4);
    o[0] = b0[0]; o[1] = b0[1]; o[2] = b0[2]; o[3] = b0[3]; o[4] = b1[0]; o[5] = b1[1]; o[6] = b1[2]; o[7] = b1[3];
#pragma unroll
    for (int k = 0; k < 4; ++k) {
        v4u x = (v4u){0u, 0u, 0u, 0u};
        if (pos - 3 + k >= 0) x = *(const GAS v4u*)(pr + (k - 3) * NP);
        if (k == 3) raw = x;
        const f32x4 w0 = *(const GAS f32x4*)(w + k * wstride), w1 = *(const GAS f32x4*)(w + k * wstride + 4);
        o[0] += w0[0] * lo16(x.x); o[1] += w0[1] * hi16(x.x); o[2] += w0[2] * lo16(x.y); o[3] += w0[3] * hi16(x.y);
        o[4] += w1[0] * lo16(x.z); o[5] += w1[1] * hi16(x.z); o[6] += w1[2] * lo16(x.w); o[7] += w1[3] * hi16(x.w);
    }
    if (SILU) {
#pragma unroll
        for (int i = 0; i < 8; ++i) o[i] = siluf_(o[i]);
    }
}
template <bool SILU> __device__ __forceinline__ void conv_t8(const bf16* pc, int pos0, const float* w, int wstride, float bias, float (&o)[8]) {
    float x[11];
#pragma unroll
    for (int i = 0; i < 11; ++i) { x[i] = 0.f; if (pos0 + i - 3 >= 0) x[i] = bf2f((unsigned)*(const GAS bf16*)(pc + (i - 3) * NP)); }
    const float w0 = w[0], w1 = w[wstride], w2 = w[2 * wstride], w3 = w[3 * wstride];
#pragma unroll
    for (int i = 0; i < 8; ++i) { float v = bias + w0 * x[i] + w1 * x[i + 1] + w2 * x[i + 2] + w3 * x[i + 3]; o[i] = SILU ? siluf_(v) : v; }
}

template <bool SMALL> __device__ __forceinline__ void tr_item(const float* src, int ldw, int srccol0, int k0, bf16* dst, int ldo, int dstrow0, const float* gain, float scal, LAS float* scr, int lane) {
    const int nn = lane & 31;
    int sc = srccol0 + nn; bool ok = true;
    if (SMALL) { sc = nn < 8 ? 1024 + nn : 3592 + (nn - 8); ok = nn < 16; }
    float v[32];
#pragma unroll
    for (int i = 0; i < 32; ++i) { const int kk = 2 * i + (lane >> 5); v[i] = ok ? *(const GAS float*)(src + (size_t)(k0 + kk) * ldw + sc) : 0.f; }
    const int c = lane & 7;
    f32x4 g0 = (f32x4){scal, scal, scal, scal}, g1 = g0;
    if (gain) { g0 = *(const GAS f32x4*)(gain + k0 + 8 * c) * scal; g1 = *(const GAS f32x4*)(gain + k0 + 8 * c + 4) * scal; }
    __builtin_amdgcn_sched_barrier(0);
#pragma unroll
    for (int i = 0; i < 32; ++i) { const int kk = 2 * i + (lane >> 5); scr[kk * 33 + nn] = v[i]; }
    LDS_WAIT(); asm volatile("" ::: "memory");
#pragma unroll
    for (int j = 0; j < 4; ++j) { const int n = (lane >> 3) + 8 * j; const LAS float* s = scr + (8 * c) * 33 + n;
        v4u o; o.x = pk2(s[0 * 33] * g0[0], s[1 * 33] * g0[1]); o.y = pk2(s[2 * 33] * g0[2], s[3 * 33] * g0[3]); o.z = pk2(s[4 * 33] * g1[0], s[5 * 33] * g1[1]); o.w = pk2(s[6 * 33] * g1[2], s[7 * 33] * g1[3]);
        if (!SMALL || n < 16) *(GAS v4u*)(dst + (size_t)(dstrow0 + n) * ldo + k0 + 8 * c) = o; }
    LDS_WAIT(); asm volatile("" ::: "memory");
}
__device__ __forceinline__ int pcol_src(int n0) {
    if (n0 < 512) return n0;
    if (n0 < 1024) return 1032 + (n0 - 512);
    if (n0 < 2048) return 2568 + (n0 - 1024);
    if (n0 < 2560) return 512 + (n0 - 2048);
    if (n0 < 3072) return 1544 + (n0 - 2560);
    return 2056 + (n0 - 3072);
}
__device__ __forceinline__ void p0_prologue(const Frame& F) {
    LAS float* scr = (LAS float*)(F.lds + RING_OFF + F.wave * 16384);
    const int gw = F.vcu * NWAVES + F.wave, NGW = F.G * NWAVES;
    constexpr int I_IN = 16 * 113, I_VF = 128 * 4, I_OUT = 24 * 32, I_UP = 16 * 176, I_DN = 44 * 32, I_QKV = 3 * 4 * 8, I_AX = 2 * 8 * 2, I_LAYER = I_IN + I_OUT + I_UP + I_DN + I_QKV + I_AX + I_VF;
    for (int it = gw; it < DEPTH * I_LAYER; it += NGW) {
        const int l = it / I_LAYER; int r = it - l * I_LAYER;
        bf16* W = (bf16*)(F.ws + WS_W) + (size_t)l * W_LAYER;
        if (r < I_IN) { const int kb = r / 113, nb = r % 113; const float* src = inp(F, 5) + (size_t)l * 1024 * 3600; const float* gain = inp(F, 1) + l * 1024;
            if (nb < 112) tr_item<false>(src, 3600, pcol_src(32 * nb), 64 * kb, W + W_IN, 1024, 32 * nb, gain, 1.0f, scr, F.lane);
            else tr_item<true>(src, 3600, 0, 64 * kb, W + W_IN, 1024, 4096, gain, 1.0f, scr, F.lane);
            continue; }
        r -= I_IN;
        if (r < I_OUT) { const int kb = r / 32, nb = r % 32; tr_item<false>(inp(F, 27) + (size_t)l * 1536 * 1024, 1024, 32 * nb, 64 * kb, W + W_OUT, 1536, 32 * nb, nullptr, 1.0f, scr, F.lane); continue; }
        r -= I_OUT;
        if (r < I_UP) { const int kb = r / 176, nb = r % 176, n0 = 32 * nb, pn = n0 >> 8, wi = n0 & 255; const int sc = wi < 128 ? 128 * pn + wi : 2816 + 128 * pn + (wi - 128);
            tr_item<false>(inp(F, 28) + (size_t)l * 1024 * 5632, 5632, sc, 64 * kb, W + W_UP, 1024, n0, inp(F, 3) + l * 1024, 1.0f, scr, F.lane); continue; }
        r -= I_UP;
        if (r < I_DN) { const int kb = r / 32, nb = r % 32; tr_item<false>(inp(F, 31) + (size_t)l * 2816 * 1024, 1024, 32 * nb, 64 * kb, W + W_DN, 2816, 32 * nb, nullptr, 1.0f, scr, F.lane); continue; }
        r -= I_DN;
        if (r < I_QKV) { const int which = r / 32, h = (r % 32) / 8, kb = (r % 8) / 4, nb = r % 4;
            const float* src = (which == 0 ? inp(F, 8) : which == 1 ? inp(F, 9) : inp(F, 10)) + ((size_t)l * 4 + h) * 16384;
            tr_item<false>(src, 128, 32 * nb, 64 * kb, W + W_Q + (size_t)which * 65536 + h * 16384, 128, 32 * nb, nullptr, which == 1 ? 0.08838834764831845f : 1.0f, scr, F.lane); continue; }
        r -= I_QKV;
        if (r < I_AX) { const int which = r / 16, n = (r % 16) / 2, nb = r % 2;
            const float* src = (which == 0 ? inp(F, 16) : inp(F, 18)) + ((size_t)l * 8 + n) * 4096;
            tr_item<false>(src, 64, 32 * nb, 0, W + (which == 0 ? W_A : W_X) + n * 4096, 64, 32 * nb, nullptr, 1.0f, scr, F.lane); continue; }
        r -= I_AX;
        {
            const int kb = r >> 2, h = r & 3; const float* wi = inp(F, 5) + (size_t)l * 1024 * 3600 + (size_t)(kb * 8) * 3600 + h * 128; const float* wv = inp(F, 10) + ((size_t)l * 4 + h) * 16384;
            float a0[8], a1[8];
#pragma unroll
            for (int kk = 0; kk < 8; ++kk) { a0[kk] = 0.f; a1[kk] = 0.f; }
#pragma unroll 1
            for (int d0 = 0; d0 < 128; d0 += 8) { float b0[8], b1[8], xs[8][8];
#pragma unroll
                for (int dd = 0; dd < 8; ++dd) { b0[dd] = *(const GAS float*)(wv + (d0 + dd) * 128 + F.lane); b1[dd] = *(const GAS float*)(wv + (d0 + dd) * 128 + 64 + F.lane);
#pragma unroll
                    for (int kk = 0; kk < 8; ++kk) xs[kk][dd] = *(const GAS float*)(wi + (size_t)kk * 3600 + d0 + dd); }
                __builtin_amdgcn_sched_barrier(0);
#pragma unroll
                for (int dd = 0; dd < 8; ++dd)
#pragma unroll
                    for (int kk = 0; kk < 8; ++kk) { a0[kk] += xs[kk][dd] * b0[dd]; a1[kk] += xs[kk][dd] * b1[dd]; } }
            bf16* dst = W + W_IN + (size_t)(3584 + h * 128) * 1024 + kb * 8;
            const f32x4 g0 = *(const GAS f32x4*)(inp(F, 1) + l * 1024 + kb * 8), g1 = *(const GAS f32x4*)(inp(F, 1) + l * 1024 + kb * 8 + 4);
            v4u o0, o1; o0.x = pk2(a0[0] * g0[0], a0[1] * g0[1]); o0.y = pk2(a0[2] * g0[2], a0[3] * g0[3]); o0.z = pk2(a0[4] * g1[0], a0[5] * g1[1]); o0.w = pk2(a0[6] * g1[2], a0[7] * g1[3]);
            o1.x = pk2(a1[0] * g0[0], a1[1] * g0[1]); o1.y = pk2(a1[2] * g0[2], a1[3] * g0[3]); o1.z = pk2(a1[4] * g1[0], a1[5] * g1[1]); o1.w = pk2(a1[6] * g1[2], a1[7] * g1[3]);
            *(GAS v4u*)(dst + (size_t)F.lane * 1024) = o0; *(GAS v4u*)(dst + (size_t)(F.lane + 64) * 1024) = o1; }
    }
    bf16* XN = (bf16*)(F.ws + WS_XN);
    for (int m = gw; m < TOK; m += NGW) {
        const GAS f32x4* xr = (const GAS f32x4*)(inp(F, 0) + (size_t)m * DM) + F.lane;
        f32x4 v[4]; float s = 0.f;
#pragma unroll
        for (int j = 0; j < 4; ++j) { v[j] = xr[64 * j]; s += (v[j][0] * v[j][0] + v[j][1] * v[j][1]) + (v[j][2] * v[j][2] + v[j][3] * v[j][3]); }
        const float rs = 1.0f / sqrtf(wave_sum(s) * (1.0f / DM) + EPS);
        GAS v2u* o8 = (GAS v2u*)(XN + (size_t)m * DM) + F.lane;
#pragma unroll
        for (int j = 0; j < 4; ++j) { v2u w; w.x = pk2(v[j][0] * rs, v[j][1] * rs); w.y = pk2(v[j][2] * rs, v[j][3] * rs); o8[64 * j] = w; }
    }
}

__device__ __forceinline__ void small_cols(const Frame& F, int l) {
    const bf16* XN = (const bf16*)(F.ws + WS_XN); const bf16* Ws = wlayer(F, l) + W_IN + (size_t)4096 * 1024; float* PS = (float*)(F.ws + WS_PS);
    const int q = F.lane >> 4, i = F.lane & 15;
    for (int rb = blockIdx.x * NWAVES + F.wave; rb < TOK / 16; rb += F.G * NWAVES) {
        const bf16* ap = XN + (size_t)(rb * 16 + i) * DM + 8 * q; const bf16* bp = Ws + (size_t)i * DM + 8 * q;
        f32x4 acc = (f32x4){0.f, 0.f, 0.f, 0.f};
#pragma unroll 8
        for (int kk = 0; kk < 32; ++kk) acc = MFMA16(ldg8(bp + 32 * kk), ldg8(ap + 32 * kk), acc);
        *(GAS f32x4*)(PS + (size_t)(rb * 16 + i) * 16 + 4 * q) = acc;
    }
}
constexpr size_t GT_MEW = 0, GT_MBC = 131072, GT_MG = 262144, GT_MPM = 393216, GT_SDT = 524288, GT_SAC = 786432, GT_SDW = 1048576;
__device__ __forceinline__ void gate_prepass(const Frame& F, int l) {
    float* GT = (float*)(F.ws + WS_GT); float* MS = (float*)(F.ws + WS_MS); const int lane = F.lane;
    for (int job = F.vcu * NWAVES + F.wave; job < 512 * 12; job += F.G * NWAVES) { const int bc = job / 12, hs = job - bc * 12, b = bc >> 6, c = bc & 63;
        const float* PS = (const float*)(F.ws + WS_PS) + (size_t)(b * SEQ + c * 64 + lane) * 16;
        if (hs < 4) { const int h = hs, item = (b * 4 + h) * 64 + c;
            const float li = *(const GAS float*)(PS + h) + inp(F, 11)[l * 4 + h], lf = logsigmoidf_(*(const GAS float*)(PS + 4 + h) + inp(F, 12)[l * 4 + h]);
            const float bcs = wave_incl_sum(lf, lane), bt = __shfl(bcs, 63), w = bt - bcs + li, ml = wave_maxf(w), g = li - bcs, pm = wave_incl_max(g, lane);
            const size_t o = (size_t)item * 64 + lane;
            *(GAS float*)(GT + GT_MEW + o) = __expf(w - ml); *(GAS float*)(GT + GT_MBC + o) = bcs; *(GAS float*)(GT + GT_MG + o) = g; *(GAS float*)(GT + GT_MPM + o) = pm;
            if (lane == 0) { *(GAS float*)(MS + item) = ml; *(GAS float*)(MS + 2048 + item) = bt; }
        } else { const int h = hs - 4, sitem = (b * 8 + h) * 64 + c;
            const float dt = softplusf_(*(const GAS float*)(PS + 8 + h) + inp(F, 23)[l * 8 + h]), a = -dt * __expf(inp(F, 24)[l * 8 + h]);
            const float ac = wave_incl_sum(a, lane), al = __shfl(ac, 63);
            const size_t o = (size_t)sitem * 64 + lane;
            *(GAS float*)(GT + GT_SDT + o) = dt; *(GAS float*)(GT + GT_SAC + o) = ac; *(GAS float*)(GT + GT_SDW + o) = dt * __expf(al - ac);
            if (lane == 63) *(GAS float*)(MS + 8192 + sitem) = __expf(al); }
    }
}
template <bool SC, int NIT> __device__ __forceinline__ void load_T(const bf16* X, LAS bf16* OT, const float* sc, int tid) {
    v4u w[NIT]; float s[NIT];
#pragma unroll
    for (int it = 0; it < NIT; ++it) { const int u = tid + NTHR * it, t = u & 63, cg = u >> 6; w[it] = *(const GAS v4u*)(X + (size_t)t * NP + cg * 8); s[it] = SC ? *(const GAS float*)(sc + (size_t)(cg >> 3) * 4096 + t) : 1.0f; }
    __builtin_amdgcn_sched_barrier(0);
#pragma unroll
    for (int it = 0; it < NIT; ++it) { const int u = tid + NTHR * it, t = u & 63, cg = u >> 6; LAS bf16* o = OT + (cg * 8) * 72 + t; const v4u ww = w[it];
        if (SC) { const float f[8] = {lo16(ww.x), hi16(ww.x), lo16(ww.y), hi16(ww.y), lo16(ww.z), hi16(ww.z), lo16(ww.w), hi16(ww.w)};
#pragma unroll
            for (int j = 0; j < 8; ++j) o[j * 72] = (bf16)f2bf(f[j] * s[it]); }
        else { o[0] = (bf16)(ww.x & 0xffffu); o[72] = (bf16)(ww.x >> 16); o[144] = (bf16)(ww.y & 0xffffu); o[216] = (bf16)(ww.y >> 16);
               o[288] = (bf16)(ww.z & 0xffffu); o[360] = (bf16)(ww.z >> 16); o[432] = (bf16)(ww.w & 0xffffu); o[504] = (bf16)(ww.w >> 16); } }
}
__device__ __forceinline__ void load_R128(const bf16* X, LAS bf16* O, int tid) {
    v4u w[2];
#pragma unroll
    for (int it = 0; it < 2; ++it) { const int u = tid + NTHR * it, t = u >> 4, cg = u & 15; w[it] = *(const GAS v4u*)(X + (size_t)t * NP + cg * 8); }
    __builtin_amdgcn_sched_barrier(0);
#pragma unroll
    for (int it = 0; it < 2; ++it) { const int u = tid + NTHR * it, t = u >> 4, cg = u & 15; *(LAS v4u*)(O + t * 136 + cg * 8) = w[it]; }
}

constexpr int ML_LOC_BYTES = 64 * 136 * 2 + 2 * 128 * 72 * 2, ML_OUT_BYTES = 3 * 64 * 136 * 2 + 128 * 72 * 2 + 64 * 72 * 2 + 7 * 256;
template <int NB> __device__ __forceinline__ void mlstm_local(const Frame& F, int l, int it0, int stride) {
    const int lane = F.lane, q = lane >> 4, i = lane & 15;
    const bf16* WkT = wlayer(F, l) + W_K; const float* GT = (const float*)(F.ws + WS_GT);
    bf16x8 af[NB][4]; f32x4 ew[NB][4];
    {   v4u wv[NB][2], wx[NB][2];
#pragma unroll
        for (int j = 0; j < NB; ++j) { const int item = it0 + j * stride, c = item & 63, bh = item >> 6, h = bh & 3, b = bh >> 2;
            const bf16* Pt = (const bf16*)(F.ws + WS_P) + (size_t)(b * SEQ + c * 64) * NP;
#pragma unroll
            for (int it = 0; it < 2; ++it) { const int u = F.tid + NTHR * it; wv[j][it] = *(const GAS v4u*)(Pt + PC_V + h * 128 + (size_t)(u & 63) * NP + (u >> 6) * 8); wx[j][it] = *(const GAS v4u*)(Pt + PC_XC + h * 128 + (size_t)(u >> 4) * NP + (u & 15) * 8); }
#pragma unroll
            for (int kk = 0; kk < 4; ++kk) af[j][kk] = ldg8(WkT + h * 16384 + (size_t)(F.wave * 16 + i) * 128 + 8 * q + 32 * kk);
#pragma unroll
            for (int st = 0; st < 4; ++st) ew[j][st] = *(const GAS f32x4*)(GT + GT_MEW + (size_t)item * 64 + st * 16 + 4 * q); }
        __builtin_amdgcn_sched_barrier(0);
#pragma unroll
        for (int j = 0; j < NB; ++j) { LAS bf16* XC = (LAS bf16*)(F.lds + j * ML_LOC_BYTES); LAS bf16* VT = XC + 64 * 136 + 128 * 72;
#pragma unroll
            for (int it = 0; it < 2; ++it) { const int u = F.tid + NTHR * it; *(LAS v4u*)(XC + (u >> 4) * 136 + (u & 15) * 8) = wx[j][it];
                LAS bf16* o = VT + ((u >> 6) * 8) * 72 + (u & 63); const v4u ww = wv[j][it];
                o[0] = (bf16)(ww.x & 0xffffu); o[72] = (bf16)(ww.x >> 16); o[144] = (bf16)(ww.y & 0xffffu); o[216] = (bf16)(ww.y >> 16);
                o[288] = (bf16)(ww.z & 0xffffu); o[360] = (bf16)(ww.z >> 16); o[432] = (bf16)(ww.w & 0xffffu); o[504] = (bf16)(ww.w >> 16); } } }
    __syncthreads();
#pragma unroll
    for (int j = 0; j < NB; ++j) { LAS bf16* XC = (LAS bf16*)(F.lds + j * ML_LOC_BYTES); LAS bf16* EKT = XC + 64 * 136;
#pragma unroll
        for (int st = 0; st < 4; ++st) { f32x4 acc = (f32x4){0.f, 0.f, 0.f, 0.f};
#pragma unroll
            for (int kk = 0; kk < 4; ++kk) acc = MFMA16(ldl8(XC + (st * 16 + i) * 136 + 8 * q + 32 * kk), af[j][kk], acc);
            acc = acc * ew[j][st];
            *(LAS v2u*)(EKT + (F.wave * 16 + i) * 72 + st * 16 + 4 * q) = pack4(acc); } }
    __syncthreads();
#pragma unroll
    for (int j = 0; j < NB; ++j) { const int item = it0 + j * stride;
        LAS bf16* EKT = (LAS bf16*)(F.lds + j * ML_LOC_BYTES) + 64 * 136; LAS bf16* VT = EKT + 128 * 72;
        bf16* CT = (bf16*)(F.ws + WS_MC) + (size_t)item * 16384;
        bf16x8 a2[2];
#pragma unroll
        for (int kk = 0; kk < 2; ++kk) a2[kk] = ldl8(VT + (F.wave * 16 + i) * 72 + 8 * q + 32 * kk);
#pragma unroll
        for (int dt = 0; dt < 8; ++dt) { f32x4 acc = (f32x4){0.f, 0.f, 0.f, 0.f};
#pragma unroll
            for (int kk = 0; kk < 2; ++kk) acc = MFMA16(ldl8(EKT + (dt * 16 + i) * 72 + 8 * q + 32 * kk), a2[kk], acc);
            *(GAS v2u*)(CT + (size_t)(F.wave * 16 + i) * 128 + dt * 16 + 4 * q) = pack4(acc); }
        if (F.tid < 128) { float s = 0.f;
#pragma unroll
            for (int jj = 0; jj < 8; ++jj) { const v4u w = *(const LAS v4u*)(EKT + F.tid * 72 + 8 * jj); s += (lo16(w.x) + hi16(w.x)) + (lo16(w.y) + hi16(w.y)) + (lo16(w.z) + hi16(w.z)) + (lo16(w.w) + hi16(w.w)); }
            *(GAS float*)((float*)(F.ws + WS_MN) + (size_t)item * 128 + F.tid) = s; } }
    __syncthreads();
}
__device__ __forceinline__ void mlstm_out(const Frame& F, int l, int item) {
    const int lane = F.lane, q = lane >> 4, i = lane & 15, c = item & 63, bh = item >> 6, h = bh & 3, b = bh >> 2;
    const bf16* Wl = wlayer(F, l); const float* GT = (const float*)(F.ws + WS_GT); const float* MS = (const float*)(F.ws + WS_MS);
    LAS bf16* XC = (LAS bf16*)F.lds; LAS bf16* Q = XC + 64 * 136; LAS bf16* K = Q + 64 * 136; LAS bf16* VT = K + 64 * 136; LAS bf16* SC = VT + 128 * 72;
    LAS float* GV = (LAS float*)(SC + 64 * 72); LAS float* AL = GV + 64; LAS float* EI = AL + 64; LAS float* EM = EI + 64; LAS float* DEN = EM + 64; LAS float* QN = DEN + 64; LAS float* SS = QN + 64;
    const bf16* Pt = (const bf16*)(F.ws + WS_P) + (size_t)(b * SEQ + c * 64) * NP;
    bf16* Pm = (bf16*)(F.ws + WS_P) + (size_t)(b * SEQ + c * 64) * NP + PC_OM + h * 128;
    bf16x8 bq[4], bk[4];
    {
        v4u wv[2], wx[2]; float g0 = 0.f, g1 = 0.f, g2 = 0.f, g3 = 0.f;
#pragma unroll
        for (int it = 0; it < 2; ++it) { const int u = F.tid + NTHR * it; wv[it] = *(const GAS v4u*)(Pt + PC_V + h * 128 + (size_t)(u & 63) * NP + (u >> 6) * 8); wx[it] = *(const GAS v4u*)(Pt + PC_XC + h * 128 + (size_t)(u >> 4) * NP + (u & 15) * 8); }
#pragma unroll
        for (int kk = 0; kk < 4; ++kk) { bq[kk] = ldg8(Wl + W_Q + h * 16384 + (size_t)(F.wave * 16 + i) * 128 + 8 * q + 32 * kk); bk[kk] = ldg8(Wl + W_K + h * 16384 + (size_t)(F.wave * 16 + i) * 128 + 8 * q + 32 * kk); }
        if (F.tid < 64) { const size_t o = (size_t)item * 64 + F.tid; g0 = *(const GAS float*)(GT + GT_MBC + o); g1 = *(const GAS float*)(GT + GT_MG + o); g2 = *(const GAS float*)(GT + GT_MPM + o); g3 = *(const GAS float*)(MS + 4096 + item); }
        __builtin_amdgcn_sched_barrier(0);
#pragma unroll
        for (int it = 0; it < 2; ++it) { const int u = F.tid + NTHR * it; *(LAS v4u*)(XC + (u >> 4) * 136 + (u & 15) * 8) = wx[it];
            LAS bf16* o = VT + ((u >> 6) * 8) * 72 + (u & 63); const v4u ww = wv[it];
            o[0] = (bf16)(ww.x & 0xffffu); o[72] = (bf16)(ww.x >> 16); o[144] = (bf16)(ww.y & 0xffffu); o[216] = (bf16)(ww.y >> 16);
            o[288] = (bf16)(ww.z & 0xffffu); o[360] = (bf16)(ww.z >> 16); o[432] = (bf16)(ww.w & 0xffffu); o[504] = (bf16)(ww.w >> 16); }
        if (F.tid < 64) { const float il = g0 + g3, mt = fmaxf(il, g0 + g2);
            GV[F.tid] = g1; AL[F.tid] = g0 - mt; EI[F.tid] = __expf(il - mt); EM[F.tid] = __expf(-mt); DEN[F.tid] = 0.f; SS[F.tid] = 0.f; }
    }
    __syncthreads();
    bf16x8 cf[4]; v2u ow[4];
    {
        const bf16* CT = (const bf16*)(F.ws + WS_MC) + (size_t)item * 16384;
#pragma unroll
        for (int kk = 0; kk < 4; ++kk) cf[kk] = ldg8(CT + (size_t)(F.wave * 16 + i) * 128 + 8 * q + 32 * kk);
#pragma unroll
        for (int tt = 0; tt < 4; ++tt) ow[tt] = *(const GAS v2u*)(Pm + (size_t)(tt * 16 + i) * NP + F.wave * 16 + 4 * q);
        __builtin_amdgcn_sched_barrier(0);
#pragma unroll
        for (int st = 0; st < 4; ++st) { f32x4 aq = (f32x4){0.f, 0.f, 0.f, 0.f}, ak = (f32x4){0.f, 0.f, 0.f, 0.f};
#pragma unroll
            for (int kk = 0; kk < 4; ++kk) { const bf16x8 xa = ldl8(XC + (st * 16 + i) * 136 + 8 * q + 32 * kk); aq = MFMA16(bq[kk], xa, aq); ak = MFMA16(bk[kk], xa, ak); }
            *(LAS v2u*)(Q + (st * 16 + i) * 136 + F.wave * 16 + 4 * q) = pack4(aq); *(LAS v2u*)(K + (st * 16 + i) * 136 + F.wave * 16 + 4 * q) = pack4(ak); }
    }
    __syncthreads();
    {
        const int tq = F.tid >> 3, part = F.tid & 7; const float* NS = (const float*)(F.ws + WS_MN) + (size_t)item * 128 + part * 16;
        const f32x4 n0 = *(const GAS f32x4*)NS, n1 = *(const GAS f32x4*)(NS + 4), n2 = *(const GAS f32x4*)(NS + 8), n3 = *(const GAS f32x4*)(NS + 12);
        __builtin_amdgcn_sched_barrier(0);
#pragma unroll
        for (int r2 = 0; r2 < 2; ++r2) { const int tile = F.wave + 8 * r2, tt = tile >> 2, st = tile & 3;
            f32x4 acc = (f32x4){0.f, 0.f, 0.f, 0.f};
            if (st <= tt) {
#pragma unroll
                for (int kk = 0; kk < 4; ++kk) acc = MFMA16(ldl8(K + (st * 16 + i) * 136 + 8 * q + 32 * kk), ldl8(Q + (tt * 16 + i) * 136 + 8 * q + 32 * kk), acc);
                const int t = tt * 16 + i; const float al = AL[t]; const f32x4 g4 = *(const LAS f32x4*)(GV + st * 16 + 4 * q); float rs = 0.f;
#pragma unroll
                for (int r = 0; r < 4; ++r) { const int s_ = st * 16 + 4 * q + r; const float f = (s_ <= t) ? __expf(al + g4[r]) : 0.f; acc[r] *= f; rs += acc[r]; }
                rs += __shfl_xor(rs, 16); rs += __shfl_xor(rs, 32);
                if (q == 0) lds_addf(DEN + t, rs);
            }
            *(LAS v2u*)(SC + (tt * 16 + i) * 72 + st * 16 + 4 * q) = pack4(acc); }
        { const v4u w0 = *(const LAS v4u*)(Q + tq * 136 + part * 16), w1 = *(const LAS v4u*)(Q + tq * 136 + part * 16 + 8);
          float s = lo16(w0.x) * n0[0] + hi16(w0.x) * n0[1] + lo16(w0.y) * n0[2] + hi16(w0.y) * n0[3] + lo16(w0.z) * n1[0] + hi16(w0.z) * n1[1] + lo16(w0.w) * n1[2] + hi16(w0.w) * n1[3]
                  + lo16(w1.x) * n2[0] + hi16(w1.x) * n2[1] + lo16(w1.y) * n2[2] + hi16(w1.y) * n2[3] + lo16(w1.z) * n3[0] + hi16(w1.z) * n3[1] + lo16(w1.w) * n3[2] + hi16(w1.w) * n3[3];
          s += __shfl_xor(s, 1); s += __shfl_xor(s, 2); s += __shfl_xor(s, 4);
          if (part == 0) QN[tq] = s; }
    }
    __syncthreads();
    f32x4 hv[4];
    {
        const int e0 = F.wave * 16;
        bf16x8 vf[2];
#pragma unroll
        for (int kk = 0; kk < 2; ++kk) vf[kk] = ldl8(VT + (e0 + i) * 72 + 8 * q + 32 * kk);
#pragma unroll
        for (int tt = 0; tt < 4; ++tt) { f32x4 a1 = (f32x4){0.f, 0.f, 0.f, 0.f}, a2 = (f32x4){0.f, 0.f, 0.f, 0.f};
#pragma unroll
            for (int kk = 0; kk < 2; ++kk) a1 = MFMA16(vf[kk], ldl8(SC + (tt * 16 + i) * 72 + 8 * q + 32 * kk), a1);
#pragma unroll
            for (int kk = 0; kk < 4; ++kk) a2 = MFMA16(cf[kk], ldl8(Q + (tt * 16 + i) * 136 + 8 * q + 32 * kk), a2);
            const int t = tt * 16 + i; const float ei = EI[t], den = DEN[t] + ei * QN[t], inv = 1.0f / fmaxf(fabsf(den), EM[t]);
            f32x4 o; o[0] = sigmoidf_(lo16(ow[tt].x)); o[1] = sigmoidf_(hi16(ow[tt].x)); o[2] = sigmoidf_(lo16(ow[tt].y)); o[3] = sigmoidf_(hi16(ow[tt].y));
            float ss = 0.f;
#pragma unroll
            for (int r = 0; r < 4; ++r) { const float v = (a1[r] + ei * a2[r]) * inv * o[r]; hv[tt][r] = v; ss += v * v; }
            ss += __shfl_xor(ss, 16); ss += __shfl_xor(ss, 32);
            if (q == 0) lds_addf(SS + t, ss); }
    }
    __syncthreads();
    {   const f32x4 gn = *(const GAS f32x4*)(inp(F, 13) + l * 512 + h * 128 + F.wave * 16 + 4 * q);
#pragma unroll
        for (int tt = 0; tt < 4; ++tt) { const int t = tt * 16 + i; const float rn = 1.0f / sqrtf(SS[t] * (1.0f / 128.0f) + EPS);
            *(GAS v2u*)(Pm + (size_t)t * NP + F.wave * 16 + 4 * q) = pack4(hv[tt] * rn * gn); } }
    __syncthreads();
}

constexpr int SSD_LOC_BYTES = (256 + 128) * 72 * 2;
template <int NB> __device__ __forceinline__ void ssd_local(const Frame& F, int l, int it0, int stride) {
    const int lane = F.lane, q = lane >> 4, i = lane & 15;
    const float* GT = (const float*)(F.ws + WS_GT);
#pragma unroll
    for (int j = 0; j < NB; ++j) { const int item = it0 + j * stride, g = item & 1, bc = item >> 1, c = bc & 63, b = bc >> 6;
        LAS bf16* XWT = (LAS bf16*)(F.lds + j * SSD_LOC_BYTES); LAS bf16* BMT = XWT + 256 * 72;
        const bf16* Pt = (const bf16*)(F.ws + WS_P) + (size_t)(b * SEQ + c * 64) * NP + PC_XBC;
        load_T<false, 2>(Pt + 512 + g * 128, BMT, GT, F.tid);
        load_T<true, 4>(Pt + g * 256, XWT, GT + GT_SDW + ((size_t)(b * 8 + 4 * g) * 64 + c) * 64, F.tid); }
    __syncthreads();
#pragma unroll
    for (int j = 0; j < NB; ++j) { const int item = it0 + j * stride, g = item & 1, bc = item >> 1, c = bc & 63, b = bc >> 6;
        LAS bf16* XWT = (LAS bf16*)(F.lds + j * SSD_LOC_BYTES); LAS bf16* BMT = XWT + 256 * 72;
        bf16* SST = (bf16*)(F.ws + WS_SS);
#pragma unroll
        for (int mi = 0; mi < 2; ++mi) { const int mt = 2 * F.wave + mi, hp = mt * 16 + i, hh = hp >> 6, p = hp & 63;
            bf16x8 af[2];
#pragma unroll
            for (int kk = 0; kk < 2; ++kk) af[kk] = ldl8(XWT + hp * 72 + 8 * q + 32 * kk);
            bf16* dst = SST + ((size_t)((b * 8 + 4 * g + hh) * 64 + c)) * 8192 + (size_t)p * 128;
#pragma unroll
            for (int nt = 0; nt < 8; ++nt) { f32x4 acc = (f32x4){0.f, 0.f, 0.f, 0.f};
#pragma unroll
                for (int kk = 0; kk < 2; ++kk) acc = MFMA16(ldl8(BMT + (nt * 16 + i) * 72 + 8 * q + 32 * kk), af[kk], acc);
                *(GAS v2u*)(dst + nt * 16 + 4 * q) = pack4(acc); } } }
    __syncthreads();
}
__device__ __forceinline__ void ssd_out(const Frame& F, int l, int item) {
    const int c = item & 63, b = item >> 6, lane = F.lane, q = lane >> 4, i = lane & 15;
    LAS bf16* XDT = (LAS bf16*)F.lds; LAS bf16* CB = XDT + 256 * 72;
    LAS float* SS = (LAS float*)(CB + 4 * 64 * 72);
    const float* GT = (const float*)(F.ws + WS_GT);
    const bf16* Pt = (const bf16*)(F.ws + WS_P) + (size_t)(b * SEQ + c * 64) * NP + PC_XBC;
    bf16* Pz = (bf16*)(F.ws + WS_P) + (size_t)(b * SEQ + c * 64) * NP + PC_ZS;
    if (F.tid < 64) SS[F.tid] = 0.f;
#pragma unroll 1
    for (int g = 0; g < 2; ++g) {
        const bf16* PB = Pt + 512 + g * 128; const bf16* PC = Pt + 768 + g * 128;
        const size_t gbase = ((size_t)(b * 8 + 4 * g) * 64 + c) * 64;
        load_T<true, 4>(Pt + g * 256, XDT, GT + GT_SDT + gbase, F.tid);
        {
#pragma unroll
            for (int r2 = 0; r2 < 2; ++r2) { const int tile = F.wave + 8 * r2, lt = tile >> 2, st = tile & 3;
                f32x4 acc = (f32x4){0.f, 0.f, 0.f, 0.f};
                if (st <= lt) { bf16x8 fb[4], fc[4];
#pragma unroll
                    for (int kk = 0; kk < 4; ++kk) { fb[kk] = ldg8(PB + (size_t)(st * 16 + i) * NP + 8 * q + 32 * kk); fc[kk] = ldg8(PC + (size_t)(lt * 16 + i) * NP + 8 * q + 32 * kk); }
                    __builtin_amdgcn_sched_barrier(0);
#pragma unroll
                    for (int kk = 0; kk < 4; ++kk) acc = MFMA16(fb[kk], fc[kk], acc); }
                const int tl = lt * 16 + i;
#pragma unroll
                for (int hh = 0; hh < 4; ++hh) { f32x4 v = (f32x4){0.f, 0.f, 0.f, 0.f};
                    if (st <= lt) { const float* ac = GT + GT_SAC + gbase + hh * 4096;
                        const float al = *(const GAS float*)(ac + tl), dsk = inp(F, 25)[l * 8 + 4 * g + hh] / *(const GAS float*)(GT + GT_SDT + gbase + hh * 4096 + tl);
                        const f32x4 as4 = *(const GAS f32x4*)(ac + st * 16 + 4 * q);
#pragma unroll
                        for (int r = 0; r < 4; ++r) { const int s = st * 16 + 4 * q + r; float f = (s <= tl) ? acc[r] * __expf(al - as4[r]) : 0.f; if (s == tl) f += dsk; v[r] = f; } }
                    *(LAS v2u*)(CB + hh * 64 * 72 + tl * 72 + st * 16 + 4 * q) = pack4(v); } }
        }
        __syncthreads();
        {
            const int hh = F.wave >> 1, h = 4 * g + hh;
            const bf16* SST = (const bf16*)(F.ws + WS_SS) + ((size_t)((b * 8 + h) * 64 + c)) * 8192;
            bf16x8 cfr[4][4];
#pragma unroll
            for (int lt = 0; lt < 4; ++lt)
#pragma unroll
                for (int kk = 0; kk < 4; ++kk) cfr[lt][kk] = ldg8(PC + (size_t)(lt * 16 + i) * NP + 8 * q + 32 * kk);
            bf16x8 sfr[2][4]; v2u zwr[2][4]; float eav[4];
#pragma unroll
            for (int pi = 0; pi < 2; ++pi) { const int pt = 2 * (F.wave & 1) + pi;
#pragma unroll
                for (int kk = 0; kk < 4; ++kk) sfr[pi][kk] = ldg8(SST + (size_t)(pt * 16 + i) * 128 + 8 * q + 32 * kk);
#pragma unroll
                for (int lt = 0; lt < 4; ++lt) zwr[pi][lt] = *(const GAS v2u*)(Pz + (size_t)(lt * 16 + i) * NP + h * 64 + pt * 16 + 4 * q); }
#pragma unroll
            for (int lt = 0; lt < 4; ++lt) eav[lt] = *(const GAS float*)(GT + GT_SAC + gbase + hh * 4096 + lt * 16 + i);
            __builtin_amdgcn_sched_barrier(0);
#pragma unroll
            for (int pi = 0; pi < 2; ++pi) { const int pt = 2 * (F.wave & 1) + pi;
                bf16x8 xf[2];
#pragma unroll
                for (int kk = 0; kk < 2; ++kk) xf[kk] = ldl8(XDT + (hh * 64 + pt * 16 + i) * 72 + 8 * q + 32 * kk);
#pragma unroll
                for (int lt = 0; lt < 4; ++lt) { f32x4 a1 = (f32x4){0.f, 0.f, 0.f, 0.f}, a2 = (f32x4){0.f, 0.f, 0.f, 0.f};
#pragma unroll
                    for (int kk = 0; kk < 2; ++kk) a1 = MFMA16(xf[kk], ldl8(CB + hh * 64 * 72 + (lt * 16 + i) * 72 + 8 * q + 32 * kk), a1);
#pragma unroll
                    for (int kk = 0; kk < 4; ++kk) a2 = MFMA16(sfr[pi][kk], cfr[lt][kk], a2);
                    const int tl = lt * 16 + i; const float ea = __expf(eav[lt]);
                    const v2u zw = zwr[pi][lt];
                    f32x4 z; z[0] = siluf_(lo16(zw.x)); z[1] = siluf_(hi16(zw.x)); z[2] = siluf_(lo16(zw.y)); z[3] = siluf_(hi16(zw.y));
                    float ss = 0.f; f32x4 yo;
#pragma unroll
                    for (int r = 0; r < 4; ++r) { const float v = (a1[r] + ea * a2[r]) * z[r]; yo[r] = v; ss += v * v; }
                    *(GAS v2u*)(Pz + (size_t)tl * NP + h * 64 + pt * 16 + 4 * q) = pack4(yo);
                    ss += __shfl_xor(ss, 16); ss += __shfl_xor(ss, 32);
                    if (q == 0) lds_addf(SS + tl, ss); } }
        }
        __syncthreads();
    }
    {
#pragma unroll
        for (int g = 0; g < 2; ++g) { const int hh = F.wave >> 1, h = 4 * g + hh;
#pragma unroll
            for (int pi = 0; pi < 2; ++pi) { const int pt = 2 * (F.wave & 1) + pi; const f32x4 gn = *(const GAS f32x4*)(inp(F, 26) + l * 512 + h * 64 + pt * 16 + 4 * q);
#pragma unroll
                for (int lt = 0; lt < 4; ++lt) { const int tl = lt * 16 + i; const float rn = 1.0f / sqrtf(SS[tl] * (1.0f / 512.0f) + EPS);
                    GAS v2u* dp = (GAS v2u*)(Pz + (size_t)tl * NP + h * 64 + pt * 16 + 4 * q); const v2u w = *dp;
                    f32x4 y; y[0] = lo16(w.x); y[1] = hi16(w.x); y[2] = lo16(w.y); y[3] = hi16(w.y);
                    *dp = pack4(y * rn * gn); } } }
    }
    __syncthreads();
}


template <bool OUT> __device__ __forceinline__ void rglru_item(const Frame& F, int l, int item) {
    const int half = item & 1, bc = item >> 1, c = bc & 63, b = bc >> 6, lane = F.lane, q = lane >> 4, i = lane & 15, ch0 = half * 256;
    LAS bf16* LA = (LAS bf16*)F.lds; LAS bf16* GI = LA + 64 * 264; LAS bf16* YB = GI + 64 * 264; LAS float* SP = (LAS float*)(YB + 64 * 264);
    const bf16* Px = (const bf16*)(F.ws + WS_P) + (size_t)(b * SEQ + c * 64) * NP + PC_XR + ch0;
    bf16* Py = (bf16*)(F.ws + WS_P) + (size_t)(b * SEQ + c * 64) * NP + PC_YR + ch0;
    if (F.tid < 256) SP[F.tid] = softplusf_(-inp(F, 20)[l * 512 + ch0 + F.tid]);
    if (OUT) {
        v4u wy[4];
#pragma unroll
        for (int it = 0; it < 4; ++it) { const int u = F.tid + NTHR * it, t = u >> 5, cg = u & 31; wy[it] = *(const GAS v4u*)(Py + (size_t)t * NP + cg * 8); }
        __builtin_amdgcn_sched_barrier(0);
#pragma unroll
        for (int it = 0; it < 4; ++it) { const int u = F.tid + NTHR * it, t = u >> 5, cg = u & 31; const v4u w = wy[it];
            float o[8] = {pg8::gelu_tanh(lo16(w.x)), pg8::gelu_tanh(hi16(w.x)), pg8::gelu_tanh(lo16(w.y)), pg8::gelu_tanh(hi16(w.y)), pg8::gelu_tanh(lo16(w.z)), pg8::gelu_tanh(hi16(w.z)), pg8::gelu_tanh(lo16(w.w)), pg8::gelu_tanh(hi16(w.w))};
            *(LAS v4u*)(YB + t * 264 + cg * 8) = pack8(o); } }
    __syncthreads();
    {
        const int gate = F.wave >> 2, blk = F.wave & 3;
        const bf16* WT = wlayer(F, l) + (gate == 0 ? W_A : W_X) + (size_t)(half * 4 + blk) * 4096;
        const float* bias = (gate == 0 ? inp(F, 17) : inp(F, 19)) + l * 512 + ch0 + blk * 64;
        bf16x8 af[4][2];
#pragma unroll
        for (int tt = 0; tt < 4; ++tt)
#pragma unroll
            for (int kk = 0; kk < 2; ++kk) af[tt][kk] = ldg8(Px + (size_t)(tt * 16 + i) * NP + blk * 64 + 8 * q + 32 * kk);
        bf16x8 bfr[4][2]; f32x4 b4r[4]; v2u xwr[4][4];
#pragma unroll
        for (int et = 0; et < 4; ++et) {
#pragma unroll
            for (int kk = 0; kk < 2; ++kk) bfr[et][kk] = ldg8(WT + (size_t)(et * 16 + i) * 64 + 8 * q + 32 * kk);
            b4r[et] = *(const GAS f32x4*)(bias + et * 16 + 4 * q);
#pragma unroll
            for (int tt = 0; tt < 4; ++tt) xwr[et][tt] = (gate == 0) ? (v2u){0u, 0u} : *(const GAS v2u*)(Px + (size_t)(tt * 16 + i) * NP + blk * 64 + et * 16 + 4 * q); }
        __builtin_amdgcn_sched_barrier(0);
#pragma unroll
        for (int et = 0; et < 4; ++et) { const bf16x8 (&bf)[2] = bfr[et];
            const f32x4 b4 = b4r[et]; const int chl = blk * 64 + et * 16 + 4 * q;
            const f32x4 sp4 = *(const LAS f32x4*)(SP + chl);
#pragma unroll
            for (int tt = 0; tt < 4; ++tt) { f32x4 acc = (f32x4){0.f, 0.f, 0.f, 0.f};
#pragma unroll
                for (int kk = 0; kk < 2; ++kk) acc = MFMA16(bf[kk], af[tt][kk], acc);
                const int t = tt * 16 + i; f32x4 o;
                if (gate == 0) {
#pragma unroll
                    for (int r = 0; r < 4; ++r) o[r] = -8.0f * sigmoidf_(acc[r] + b4[r]) * sp4[r];
                    *(LAS v2u*)(LA + t * 264 + chl) = pack4(o);
                } else { const v2u xw = xwr[et][tt];
                    o[0] = sigmoidf_(acc[0] + b4[0]) * lo16(xw.x); o[1] = sigmoidf_(acc[1] + b4[1]) * hi16(xw.x); o[2] = sigmoidf_(acc[2] + b4[2]) * lo16(xw.y); o[3] = sigmoidf_(acc[3] + b4[3]) * hi16(xw.y);
                    *(LAS v2u*)(GI + t * 264 + chl) = pack4(o); } } }
    }
    __syncthreads();
    float* RG = (float*)(F.ws + WS_RG);
    if (F.tid < 256) { const int ch = F.tid;
        float hs = OUT ? *(const GAS float*)(RG + (size_t)item * 256 + ch) : 0.f, ap = 1.0f;
#pragma unroll 8
        for (int t = 0; t < 64; ++t) { const float la = bf2f((unsigned)LA[t * 264 + ch]), gi = bf2f((unsigned)GI[t * 264 + ch]);
            const float a = __expf(la), mult = sqrtf(fmaxf(1.0f - a * a, 0.f));
            hs = a * hs + mult * gi; ap *= a;
            if (OUT) YB[t * 264 + ch] = (bf16)f2bf(hs * bf2f((unsigned)YB[t * 264 + ch])); }
        if (!OUT) { *(GAS float*)(RG + (size_t)item * 256 + ch) = ap; *(GAS float*)(RG + 262144 + (size_t)item * 256 + ch) = hs; } }
    __syncthreads();
    if (OUT) {
#pragma unroll
        for (int it = 0; it < 4; ++it) { const int u = F.tid + NTHR * it, t = u >> 5, cg = u & 31; *(GAS v4u*)(Py + (size_t)t * NP + cg * 8) = *(const LAS v4u*)(YB + t * 264 + cg * 8); }
        __syncthreads(); }
}

__device__ __forceinline__ void scans(const Frame& F) {
    const int gt = F.vcu * NTHR + F.tid, NT = F.G * NTHR;
    float* MS = (float*)(F.ws + WS_MS);
    for (int job = gt; job < 32 * 2048; job += NT) { const int sq = job >> 11, grp = job & 2047;
        bf16* p = (bf16*)(F.ws + WS_MC) + (size_t)sq * 64 * 16384 + grp * 8;
        float st[8]; float m = 0.f;
#pragma unroll
        for (int j = 0; j < 8; ++j) st[j] = 0.f;
#pragma unroll 1
        for (int c0 = 0; c0 < 64; c0 += 8) { v4u v[8]; float mlv[8], btv[8];
#pragma unroll
            for (int k = 0; k < 8; ++k) { v[k] = *(const GAS v4u*)(p + (size_t)(c0 + k) * 16384); mlv[k] = *(const GAS float*)(MS + sq * 64 + c0 + k); btv[k] = *(const GAS float*)(MS + 2048 + sq * 64 + c0 + k); }
            __builtin_amdgcn_sched_barrier(0);
#pragma unroll
            for (int k = 0; k < 8; ++k) { const int it = sq * 64 + c0 + k; const float ml = mlv[k], bt = btv[k];
                const float mn = fmaxf(bt + m, ml), sp = __expf(bt + m - mn), sl = __expf(ml - mn);
                if (grp == 0) *(GAS float*)(MS + 4096 + it) = m;
                v4u o; o.x = pk2(st[0], st[1]); o.y = pk2(st[2], st[3]); o.z = pk2(st[4], st[5]); o.w = pk2(st[6], st[7]);
                *(GAS v4u*)(p + (size_t)(c0 + k) * 16384) = o;
                st[0] = sp * st[0] + sl * lo16(v[k].x); st[1] = sp * st[1] + sl * hi16(v[k].x); st[2] = sp * st[2] + sl * lo16(v[k].y); st[3] = sp * st[3] + sl * hi16(v[k].y);
                st[4] = sp * st[4] + sl * lo16(v[k].z); st[5] = sp * st[5] + sl * hi16(v[k].z); st[6] = sp * st[6] + sl * lo16(v[k].w); st[7] = sp * st[7] + sl * hi16(v[k].w);
                m = mn; } } }
    for (int job = gt; job < 64 * 1024; job += NT) { const int sq = job >> 10, grp = job & 1023;
        bf16* p = (bf16*)(F.ws + WS_SS) + (size_t)sq * 64 * 8192 + grp * 8;
        float st[8];
#pragma unroll
        for (int j = 0; j < 8; ++j) st[j] = 0.f;
#pragma unroll 1
        for (int c0 = 0; c0 < 64; c0 += 8) { v4u v[8]; float dcv[8];
#pragma unroll
            for (int k = 0; k < 8; ++k) { v[k] = *(const GAS v4u*)(p + (size_t)(c0 + k) * 8192); dcv[k] = *(const GAS float*)(MS + 8192 + sq * 64 + c0 + k); }
            __builtin_amdgcn_sched_barrier(0);
#pragma unroll
            for (int k = 0; k < 8; ++k) { const float dc = dcv[k];
                v4u o; o.x = pk2(st[0], st[1]); o.y = pk2(st[2], st[3]); o.z = pk2(st[4], st[5]); o.w = pk2(st[6], st[7]);
                *(GAS v4u*)(p + (size_t)(c0 + k) * 8192) = o;
                st[0] = dc * st[0] + lo16(v[k].x); st[1] = dc * st[1] + hi16(v[k].x); st[2] = dc * st[2] + lo16(v[k].y); st[3] = dc * st[3] + hi16(v[k].y);
                st[4] = dc * st[4] + lo16(v[k].z); st[5] = dc * st[5] + hi16(v[k].z); st[6] = dc * st[6] + lo16(v[k].w); st[7] = dc * st[7] + hi16(v[k].w); } } }
    for (int job = gt; job < 32 * 128; job += NT) { const int sq = job >> 7, e = job & 127; float* p = (float*)(F.ws + WS_MN) + (size_t)sq * 64 * 128 + e; float st = 0.f, m = 0.f;
#pragma unroll 1
        for (int c0 = 0; c0 < 64; c0 += 16) { float v[16], ml[16], bt[16];
#pragma unroll
            for (int k = 0; k < 16; ++k) { const int it = sq * 64 + c0 + k; v[k] = *(const GAS float*)(p + (c0 + k) * 128); ml[k] = *(const GAS float*)(MS + it); bt[k] = *(const GAS float*)(MS + 2048 + it); }
            __builtin_amdgcn_sched_barrier(0);
#pragma unroll
            for (int k = 0; k < 16; ++k) { const float mn = fmaxf(bt[k] + m, ml[k]), sp = __expf(bt[k] + m - mn), sl = __expf(ml[k] - mn);
                *(GAS float*)(p + (c0 + k) * 128) = st; st = sp * st + sl * v[k]; m = mn; } } }
    for (int job = gt; job < 8 * 512; job += NT) { const int b = job >> 9, half = (job >> 8) & 1, ch = job & 255; float* RG = (float*)(F.ws + WS_RG); float h = 0.f;
#pragma unroll 1
        for (int c0 = 0; c0 < 64; c0 += 16) { float a[16], u[16];
#pragma unroll
            for (int k = 0; k < 16; ++k) { const size_t o = (size_t)(((b * 64 + c0 + k) * 2 + half)) * 256 + ch; a[k] = *(const GAS float*)(RG + o); u[k] = *(const GAS float*)(RG + 262144 + o); }
            __builtin_amdgcn_sched_barrier(0);
#pragma unroll
            for (int k = 0; k < 16; ++k) { const size_t o = (size_t)(((b * 64 + c0 + k) * 2 + half)) * 256 + ch; *(GAS float*)(RG + o) = h; h = a[k] * h + u[k]; } } }
}

__device__ __forceinline__ void rms_update(const Frame& F, const float* xold, float* xnew, const float* g, bool write_xn) {
    const int gw = F.vcu * NWAVES + F.wave, NGW = F.G * NWAVES;
    const float* Y = (const float*)(F.ws + WS_Y); bf16* XN = (bf16*)(F.ws + WS_XN);
    f32x4 gv[4];
#pragma unroll
    for (int j = 0; j < 4; ++j) gv[j] = *((const GAS f32x4*)g + F.lane + 64 * j);
    for (int m = gw; m < TOK; m += NGW) {
        const GAS f32x4* yr = (const GAS f32x4*)(Y + (size_t)m * DM) + F.lane; const GAS f32x4* xr = (const GAS f32x4*)(xold + (size_t)m * DM) + F.lane;
        f32x4 y[4], x[4]; float s = 0.f;
#pragma unroll
        for (int j = 0; j < 4; ++j) { y[j] = yr[64 * j]; x[j] = xr[64 * j]; s += (y[j][0] * y[j][0] + y[j][1] * y[j][1]) + (y[j][2] * y[j][2] + y[j][3] * y[j][3]); }
        const float r1 = 1.0f / sqrtf(wave_sum(s) * (1.0f / DM) + EPS); float s2 = 0.f;
#pragma unroll
        for (int j = 0; j < 4; ++j) { x[j] = x[j] + y[j] * r1 * gv[j]; s2 += (x[j][0] * x[j][0] + x[j][1] * x[j][1]) + (x[j][2] * x[j][2] + x[j][3] * x[j][3]); }
        GAS f32x4* xo = (GAS f32x4*)(xnew + (size_t)m * DM) + F.lane;
#pragma unroll
        for (int j = 0; j < 4; ++j) xo[64 * j] = x[j];
        if (write_xn) { const float r2 = 1.0f / sqrtf(wave_sum(s2) * (1.0f / DM) + EPS); GAS v2u* o8 = (GAS v2u*)(XN + (size_t)m * DM) + F.lane;
#pragma unroll
            for (int j = 0; j < 4; ++j) { v2u w; w.x = pk2(x[j][0] * r2, x[j][1] * r2); w.y = pk2(x[j][2] * r2, x[j][3] * r2); o8[64 * j] = w; } }
    }
}
__device__ __forceinline__ void ffn_fixup(const Frame& F, int l) {
    const int gt = F.vcu * NTHR + F.tid, NT = F.G * NTHR;
    const float* UH = (const float*)(F.ws + WS_HALO); const float* UF = UH + (size_t)128 * 2 * 5632; bf16* ACT = (bf16*)(F.ws + WS_P);
    const float* cw = inp(F, 29) + (size_t)l * 3 * 5632; const float* cb = inp(F, 30) + l * 5632;
    for (int job = gt; job < 128 * 2816; job += NT) { const int pm = job / 2816, j = job - pm * 2816;
        float o[2];
#pragma unroll
        for (int gv = 0; gv < 2; ++gv) { const int col = gv * 2816 + j;
            const float u0 = *(const GAS float*)(UF + ((size_t)pm * 2) * 5632 + col), u1 = *(const GAS float*)(UF + ((size_t)pm * 2 + 1) * 5632 + col);
            float h0 = 0.f, h1 = 0.f; if (pm & 15) { h0 = *(const GAS float*)(UH + ((size_t)(pm - 1) * 2) * 5632 + col); h1 = *(const GAS float*)(UH + ((size_t)(pm - 1) * 2 + 1) * 5632 + col); }
            const float w0 = cw[col], w1 = cw[5632 + col], w2 = cw[2 * 5632 + col], bb = cb[col];
            const float r0 = bb + w0 * h0 + w1 * h1 + w2 * u0, r1 = bb + w0 * h1 + w1 * u0 + w2 * u1;
            if (gv == 0) { o[0] = pg8::gelu_tanh(r0); o[1] = pg8::gelu_tanh(r1); } else { o[0] *= r0; o[1] *= r1; } }
        *(GAS bf16*)(ACT + (size_t)(pm * 256) * DFF + j) = (bf16)f2bf(o[0]); *(GAS bf16*)(ACT + (size_t)(pm * 256 + 1) * DFF + j) = (bf16)f2bf(o[1]); }
}
__device__ __forceinline__ void in_fixup(const Frame& F, int l) {
    const int gt = F.vcu * NTHR + F.tid, NT = F.G * NTHR;
    const float* UH = (const float*)(F.ws + WS_HALO_IN); const float* UF = UH + (size_t)128 * 3 * 2048; bf16* P = (bf16*)(F.ws + WS_P);
    for (int job = gt; job < 128 * 2048; job += NT) { const int pm = job >> 11, col = job & 2047;
        const float* cw; const float* cb; int cst, ch; bool act;
        if (col < 512) { cw = inp(F, 6) + (size_t)l * 4 * 512; cb = inp(F, 7) + l * 512; cst = 512; ch = col; act = true; }
        else if (col < 1024) { cw = inp(F, 14) + (size_t)l * 4 * 512; cb = inp(F, 15) + l * 512; cst = 512; ch = col - 512; act = false; }
        else { cw = inp(F, 21) + (size_t)l * 4 * 1024; cb = inp(F, 22) + l * 1024; cst = 1024; ch = col - 1024; act = true; }
        const float f0 = *(const GAS float*)(UF + ((size_t)pm * 3 + 0) * 2048 + col), f1 = *(const GAS float*)(UF + ((size_t)pm * 3 + 1) * 2048 + col), f2 = *(const GAS float*)(UF + ((size_t)pm * 3 + 2) * 2048 + col);
        float h0 = 0.f, h1 = 0.f, h2 = 0.f;
        if (pm & 15) { h0 = *(const GAS float*)(UH + ((size_t)(pm - 1) * 3 + 0) * 2048 + col); h1 = *(const GAS float*)(UH + ((size_t)(pm - 1) * 3 + 1) * 2048 + col); h2 = *(const GAS float*)(UH + ((size_t)(pm - 1) * 3 + 2) * 2048 + col); }
        const float w0 = *(const GAS float*)(cw + ch), w1 = *(const GAS float*)(cw + cst + ch), w2 = *(const GAS float*)(cw + 2 * cst + ch), w3 = *(const GAS float*)(cw + 3 * cst + ch), bb = *(const GAS float*)(cb + ch);
        float o0 = bb + w0 * h0 + w1 * h1 + w2 * h2 + w3 * f0, o1 = bb + w0 * h1 + w1 * h2 + w2 * f0 + w3 * f1, o2 = bb + w0 * h2 + w1 * f0 + w2 * f1 + w3 * f2;
        if (act) { o0 = pg8::silu_f(o0); o1 = pg8::silu_f(o1); o2 = pg8::silu_f(o2); }
        bf16* dst = P + (size_t)(pm * 256) * NP + col;
        *(GAS bf16*)dst = (bf16)f2bf(o0); *(GAS bf16*)(dst + NP) = (bf16)f2bf(o1); *(GAS bf16*)(dst + 2 * NP) = (bf16)f2bf(o2); }
}

__global__ void __launch_bounds__(NWAVES * 64, 2) hymba_fwd(Args args) {
    extern __shared__ __attribute__((aligned(16))) unsigned char lds[];
    Frame F;
    F.lds = (LAS unsigned char*)lds;
    F.MISC = (volatile LAS unsigned*)(F.lds + MISC_OFF);
    F.tid = threadIdx.x; F.lane = F.tid & 63; F.wave = __builtin_amdgcn_readfirstlane(F.tid >> 6);
    F.G = gridDim.x; { const int bx = blockIdx.x; F.vcu = (F.G % 8 == 0) ? (bx % 8) * (F.G / 8) + bx / 8 : bx; }
    F.ws = args.ws; F.ctl = (gu32*)(args.ws + WS_CTL);
    for (int u = F.tid; u < (LDS_BYTES - LDSCTL_OFF) / 4; u += NWAVES * 64) ((LAS unsigned*)(F.lds + LDSCTL_OFF))[u] = 0u;
    __syncthreads();
    {
        volatile LAS unsigned long long* pt = (volatile LAS unsigned long long*)(F.lds + PTR_OFF);
#pragma unroll
        for (int k = 0; k < 32; ++k) if (F.tid == k) pt[k] = (unsigned long long)args.in[k];
        if (F.tid == 32) pt[32] = (unsigned long long)args.ws;
    }
    __syncthreads();
    XcdBarrier bar; bar.bar = (unsigned*)(F.ctl + CW_BAR); bar.x = 0; bar.st = nullptr;
    if (!MK_PER_PHASE) bar = xcd_barrier_post((unsigned*)(F.ctl + CW_BAR), F.MISC + 8);
    const int lo = MK_PER_PHASE ? args.ph_lo : 0, hi = MK_PER_PHASE ? args.ph_hi : NPHASES;
    const Frame F0 = F;
#define FRESH() do { int t_ = threadIdx.x; asm volatile("" : "+v"(t_)); F = F0; asm volatile("" : "+s"(F.ws)); F.tid = t_; F.lane = t_ & 63; F.wave = __builtin_amdgcn_readfirstlane(t_ >> 6); } while (0)
#ifndef SKIPMASK
#define SKIPMASK 0
#endif
#define IN(k) (lo <= (k) && (k) < hi)
#ifndef TIMESEL
#define TIMESEL -1
#endif
    unsigned long long tacc = 0, tst = 0;
#define TB(g) do { if (TIMESEL == (g)) tst = __builtin_amdgcn_s_memrealtime(); } while (0)
#define TE(g) do { if (TIMESEL == (g)) tacc += __builtin_amdgcn_s_memrealtime() - tst; } while (0)
#define ON(b) (!((SKIPMASK >> (b)) & 1))
#define SEAM(k) do { if (!MK_PER_PHASE && IN(k) && IN((k) + 1)) { XcdBarrier b_ = bar; asm volatile("" : "+s"(b_.bar), "+s"(b_.x)); xcd_barrier(b_); } } while (0)

    if (IN(0)) { TB(0); FRESH(); if (ON(0)) p0_prologue(F); SEAM(0); TE(0); }

#pragma unroll 1
    for (int l = 0; l < DEPTH; ++l) {
        const int pb = 1 + PH_PER_LAYER * l;
        if (IN(pb + 0)) { TB(1); FRESH();
            pg8::Gemm g{(const bf16*)(F.ws + WS_XN), wlayer(F, l) + W_IN, TOK, NP, DM, DM}; pg8::StaticOrder S; S.init(TOK, NP, F.G, (int)blockIdx.x);
            pg8::EpiIn E{(bf16*)(F.ws + WS_P), F.lds + PTR_OFF, l, WS_HALO_IN, (LAS float*)(F.lds + EPI_OFF)};
            if (ON(1)) pg8::gemm_phase<pg8::EpiIn, pg8::StaticOrder, true, PG8_SP2>(F.lds + RING_OFF, g, S, E);
            FRESH(); if (ON(2)) small_cols(F, l);
            SEAM(pb + 0); TE(1);
        }
        if (IN(pb + 1)) { TB(5); FRESH(); in_fixup(F, l); FRESH(); gate_prepass(F, l); SEAM(pb + 1); TE(5); }
        if (IN(pb + 2)) { TB(2);
#pragma unroll 1
            TB(9); for (int it = F.vcu; it < 2048; it += 2 * F.G) { FRESH(); if (ON(3)) mlstm_local<2>(F, l, it, F.G); } TE(9);
#pragma unroll 1
            TB(10); for (int it = F.vcu; it < 1024; it += 2 * F.G) { FRESH(); if (ON(4)) ssd_local<2>(F, l, it, F.G); } TE(10);
#pragma unroll 1
            TB(11); for (int it = F.vcu; it < 1024; it += F.G) { FRESH(); if (ON(5)) rglru_item<false>(F, l, it); } TE(11);
            SEAM(pb + 2); TE(2);
        }
        if (IN(pb + 3)) { TB(3); FRESH(); if (ON(6)) scans(F); SEAM(pb + 3); TE(3); }
        if (IN(pb + 4)) { TB(4);
#pragma unroll 1
            TB(6); for (int it = F.vcu; it < 2048; it += F.G) { FRESH(); if (ON(7)) mlstm_out(F, l, it); } TE(6);
#pragma unroll 1
            TB(7); for (int it = F.vcu; it < 512; it += F.G) { FRESH(); if (ON(8)) ssd_out(F, l, it); } TE(7);
#pragma unroll 1
            TB(8); for (int it = F.vcu; it < 1024; it += F.G) { FRESH(); if (ON(9)) rglru_item<true>(F, l, it); } TE(8);
            SEAM(pb + 4); TE(4);
        }
        if (IN(pb + 5)) { TB(1); FRESH();
            pg8::Gemm g{(const bf16*)(F.ws + WS_P) + PC_OM, wlayer(F, l) + W_OUT, TOK, DM, KMIX, NP}; pg8::StaticOrder S; S.init(TOK, DM, F.G, (int)blockIdx.x);
            pg8::EpiF32 E{(float*)(F.ws + WS_Y), DM};
            if (ON(10)) pg8::gemm_phase<pg8::EpiF32, pg8::StaticOrder, PG8_ALIGN, PG8_SP2>(F.lds + RING_OFF, g, S, E);
            SEAM(pb + 5); TE(1);
        }
        if (IN(pb + 6)) { TB(5); FRESH(); if (ON(11)) rms_update(F, l == 0 ? inp(F, 0) : args.out, args.out, inp(F, 2) + l * DM, true); SEAM(pb + 6); TE(5); }
        if (IN(pb + 7)) { TB(1); FRESH();
            pg8::Gemm g{(const bf16*)(F.ws + WS_XN), wlayer(F, l) + W_UP, TOK, NUP, DM, DM}; pg8::StaticOrder S; S.init(TOK, NUP, F.G, (int)blockIdx.x);
            pg8::EpiConv E{(bf16*)(F.ws + WS_P), F.lds + PTR_OFF, l, WS_HALO, (LAS float*)(F.lds + EPI_OFF)};
            if (ON(12)) pg8::gemm_phase<pg8::EpiConv, pg8::StaticOrder, true, PG8_SP2>(F.lds + RING_OFF, g, S, E);
            SEAM(pb + 7); TE(1);
        }
        if (IN(pb + 8)) { TB(5); FRESH(); if (ON(13)) ffn_fixup(F, l); SEAM(pb + 8); TE(5); }
        if (IN(pb + 9)) { TB(1); FRESH();
            pg8::Gemm g{(const bf16*)(F.ws + WS_P), wlayer(F, l) + W_DN, TOK, DM, DFF, DFF}; pg8::StaticOrder S; S.init(TOK, DM, F.G, (int)blockIdx.x);
            pg8::EpiF32 E{(float*)(F.ws + WS_Y), DM};
            if (ON(14)) pg8::gemm_phase<pg8::EpiF32, pg8::StaticOrder, PG8_ALIGN, PG8_SP2>(F.lds + RING_OFF, g, S, E);
            SEAM(pb + 9); TE(1);
        }
        if (IN(pb + 10)) { TB(5); FRESH(); if (ON(15)) rms_update(F, args.out, args.out, inp(F, 4) + l * DM, l + 1 < DEPTH); SEAM(pb + 10); TE(5); }
    }
    if (TIMESEL >= 0) { const unsigned long long t0 = __builtin_amdgcn_s_memrealtime(); while (__builtin_amdgcn_s_memrealtime() - t0 < 2 * tacc) __builtin_amdgcn_s_sleep(8); }
#undef IN
#undef SEAM
}

extern "C" void kernel_launch(void* const* d_in, const int* in_sizes, int n_in, void* d_out, int out_size, void* d_ws, size_t ws_size, hipStream_t stream) {
    static int grid = 0;
    if (grid == 0) {
        if (n_in != 32 || in_sizes[0] != TOK * DM || out_size != TOK * DM || ws_size < WS_END) { fprintf(stderr, "kernel_launch: unexpected shapes: n_in %d in0 %d out %d ws %zu (need %zu)\n", n_in, n_in > 0 ? in_sizes[0] : -1, out_size, ws_size, (size_t)WS_END); grid = -1; return; }
        int dev = 0, cus = 0, per_cu = 0;
        if (hipGetDevice(&dev) != hipSuccess || hipDeviceGetAttribute(&cus, hipDeviceAttributeMultiprocessorCount, dev) != hipSuccess) { grid = -1; return; }
        if (hipFuncSetAttribute((const void*)hymba_fwd, hipFuncAttributeMaxDynamicSharedMemorySize, LDS_BYTES) != hipSuccess) { fprintf(stderr, "kernel_launch: hipFuncSetAttribute failed\n"); grid = -1; return; }
        if (hipOccupancyMaxActiveBlocksPerMultiprocessor(&per_cu, (const void*)hymba_fwd, NWAVES * 64, LDS_BYTES) != hipSuccess || per_cu < 1) fprintf(stderr, "kernel_launch: occupancy query says %d\n", per_cu);
        (void)hipGetLastError();
        grid = cus;
        if (grid != 256) fprintf(stderr, "kernel_launch: %d CUs (built for 256)\n", grid);
    }
    if (grid < 0) return;
    if (hipMemsetAsync((char*)d_ws + WS_CTL, 0, CTL_ZERO_BYTES, stream) != hipSuccess) { fprintf(stderr, "kernel_launch: memset failed\n"); return; }
    Args a{};
    for (int i = 0; i < 32; ++i) a.in[i] = (const float*)d_in[i];
    a.out = (float*)d_out; a.ws = (unsigned char*)d_ws;
#if MK_PER_PHASE
    for (int p = 0; p < NPHASES; ++p) { a.ph_lo = p; a.ph_hi = p + 1; hipLaunchKernelGGL(hymba_fwd, dim3(grid), dim3(NWAVES * 64), LDS_BYTES, stream, a); }
#else
    a.ph_lo = 0; a.ph_hi = NPHASES;
    hipLaunchKernelGGL(hymba_fwd, dim3(grid), dim3(NWAVES * 64), LDS_BYTES, stream, a);
#endif
    const hipError_t le = hipPeekAtLastError();
    if (le != hipSuccess) fprintf(stderr, "kernel_launch: launch failed: %s\n", hipGetErrorName(le));
}
```
